# Optimizing an MI355X kernel written in HIP

```python
import jax, jax.numpy as jnp
from jax import lax
import numpy as np

D_MODEL = 1024
BATCH = 8
SEQ = 4096
DEPTH = 2

RET_HEADS = 4
RET_HEAD_DIM = D_MODEL // RET_HEADS
RET_WIDTH = RET_HEADS * RET_HEAD_DIM
RET_CHUNK = 128
ROPE_BASE = 10000.0

CONV_CH = D_MODEL
CONV_K = 3

SWA_HEAD_DIM = 64
SWA_Q_HEADS = D_MODEL // SWA_HEAD_DIM
SWA_KV_HEADS = SWA_Q_HEADS // 8
SWA_WIDTH = SWA_Q_HEADS * SWA_HEAD_DIM
SWA_WINDOW = 128
SWA_BLOCK = 128

N_BRANCH = 3
D_FF = 2816
MACARON_WEIGHT = 0.5
N_MOD = 9
EPS = 1e-6

RET_COLS = 4 * RET_WIDTH
CONV_COLS = 3 * CONV_CH
SWA_COLS = (SWA_Q_HEADS + 2 * SWA_KV_HEADS) * SWA_HEAD_DIM
GATE_COLS = N_BRANCH * D_MODEL
OFF_CONV = RET_COLS
OFF_SWA = OFF_CONV + CONV_COLS
OFF_GATE = OFF_SWA + SWA_COLS
IN_COLS = OFF_GATE + GATE_COLS

kernel_name = 'hybrid_retention_shortconv_swa_macaron'


def rmsnorm(t, g):
    tf = t.astype(jnp.float32)
    n = tf * lax.rsqrt(jnp.mean(tf * tf, axis=-1, keepdims=True) + EPS)
    return n.astype(t.dtype) * g


def modulate(t, shift, scale):
    return t * (1 + scale[:, None, :]) + shift[:, None, :]


def swiglu(t, w1, w3, w2):
    return (jax.nn.silu(t @ w1) * (t @ w3)) @ w2


def rotary(t):
    S, d = t.shape[1], t.shape[-1]
    half = d // 2
    inv = jnp.power(ROPE_BASE, -jnp.linspace(0.0, 1.0, half, dtype=jnp.float32))
    ang = jnp.arange(S, dtype=jnp.float32)[:, None] * inv[None, :]
    cos = jnp.cos(ang)[None, :, None, :]
    sin = jnp.sin(ang)[None, :, None, :]
    t1, t2 = t[..., :half], t[..., half:]
    return jnp.concatenate([t1 * cos - t2 * sin, t2 * cos + t1 * sin], axis=-1)


def retention(q, k, v):
    B, S, H, dk = q.shape
    dv = v.shape[-1]
    C = RET_CHUNK
    N = S // C
    log_gamma = jnp.log1p(-jnp.exp2(-5.0 - jnp.arange(H, dtype=jnp.float32)))
    idx = jnp.arange(C, dtype=jnp.float32)
    rel = idx[:, None] - idx[None, :]
    intra = jnp.where(rel >= 0, jnp.exp(log_gamma[:, None, None] * jnp.maximum(rel, 0.0)), 0.0)
    xi = jnp.exp(log_gamma[:, None] * (idx + 1.0))[None, :, :, None]
    zeta = jnp.exp(log_gamma[:, None] * (C - 1.0 - idx))[None, :, :, None]
    chunk_decay = jnp.exp(log_gamma * C)[None, :, None, None]
    k = k * (dk ** -0.5)

    def to_chunks(t):
        return t.reshape(B, N, C, H, t.shape[-1]).transpose(1, 0, 3, 2, 4)

    def step(state, inp):
        qc, kc, vc = inp
        scores = jnp.einsum('bhid,bhjd->bhij', qc, kc) * intra[None]
        inner = jnp.einsum('bhij,bhje->bhie', scores, vc)
        cross = jnp.einsum('bhid,bhde->bhie', qc, state) * xi
        new_state = state * chunk_decay + jnp.einsum('bhjd,bhje->bhde', kc * zeta, vc)
        return new_state, inner + cross

    state0 = jnp.zeros((B, H, dk, dv), jnp.float32)
    _, out = lax.scan(step, state0, (to_chunks(q), to_chunks(k), to_chunks(v)))
    return out.transpose(1, 0, 3, 2, 4).reshape(B, S, H, dv)


def short_conv(z, w):
    S = z.shape[1]
    zp = jnp.pad(z, ((0, 0), (CONV_K - 1, 0), (0, 0)))
    y = zp[:, 0:S, :] * w[0]
    for j in range(1, CONV_K):
        y = y + zp[:, j:j + S, :] * w[j]
    return y


def swa_with_sinks(q, k, v, sinks):
    B, S, Hq, d = q.shape
    Hkv = k.shape[2]
    G = Hq // Hkv
    W = SWA_BLOCK
    N = S // W
    qb = q.reshape(B, N, W, Hkv, G, d)

    def band(t):
        tp = jnp.pad(t, ((0, 0), (W, 0), (0, 0), (0, 0)))
        prev = tp[:, :S].reshape(B, N, W, Hkv, d)
        cur = t.reshape(B, N, W, Hkv, d)
        return jnp.concatenate([prev, cur], axis=2)

    kb, vb = band(k), band(v)
    scores = jnp.einsum('bnqkgd,bnjkd->bnkgqj', qb, kb).astype(jnp.float32) * (d ** -0.5)
    i = jnp.arange(W)[:, None]
    j = jnp.arange(2 * W)[None, :]
    diff = i + W - j
    in_band = (diff >= 0) & (diff < SWA_WINDOW)
    valid = in_band[None] & ((jnp.arange(N)[:, None, None] > 0) | (j >= W)[None])
    scores = jnp.where(valid[None, :, None, None], scores, -jnp.inf)
    s = sinks.astype(jnp.float32).reshape(Hkv, G)[None, None, :, :, None, None]
    m = jnp.maximum(jnp.max(scores, axis=-1, keepdims=True), s)
    p = jnp.exp(scores - m)
    probs = p / (jnp.sum(p, axis=-1, keepdims=True) + jnp.exp(s - m))
    out = jnp.einsum('bnkgqj,bnjkd->bnqkgd', probs.astype(v.dtype), vb)
    return out.reshape(B, S, Hq * d)


def hybrid_mixer(u, w_in, conv_w, sinks, p_ret, p_conv, p_swa, w_out):
    B, S, _ = u.shape
    proj = u @ w_in
    rq = proj[..., 0:RET_WIDTH].reshape(B, S, RET_HEADS, RET_HEAD_DIM).astype(jnp.float32)
    rk = proj[..., RET_WIDTH:2 * RET_WIDTH].reshape(B, S, RET_HEADS, RET_HEAD_DIM).astype(jnp.float32)
    rv = proj[..., 2 * RET_WIDTH:3 * RET_WIDTH].reshape(B, S, RET_HEADS, RET_HEAD_DIM).astype(jnp.float32)
    rg = proj[..., 3 * RET_WIDTH:RET_COLS]
    r = retention(rotary(rq), rotary(rk), rv)
    r = r * lax.rsqrt(jnp.mean(r * r, axis=-1, keepdims=True) + EPS)
    y_a = jax.nn.silu(rg) * r.reshape(B, S, RET_WIDTH).astype(u.dtype)
    cb = proj[..., OFF_CONV:OFF_CONV + CONV_CH]
    cc = proj[..., OFF_CONV + CONV_CH:OFF_CONV + 2 * CONV_CH]
    cx = proj[..., OFF_CONV + 2 * CONV_CH:OFF_SWA]
    y_b = cb * short_conv(cc * cx, conv_w)
    kv_w = SWA_KV_HEADS * SWA_HEAD_DIM
    sq = proj[..., OFF_SWA:OFF_SWA + SWA_WIDTH].reshape(B, S, SWA_Q_HEADS, SWA_HEAD_DIM)
    sk = proj[..., OFF_SWA + SWA_WIDTH:OFF_SWA + SWA_WIDTH + kv_w].reshape(B, S, SWA_KV_HEADS, SWA_HEAD_DIM)
    sv = proj[..., OFF_SWA + SWA_WIDTH + kv_w:OFF_GATE].reshape(B, S, SWA_KV_HEADS, SWA_HEAD_DIM)
    y_c = swa_with_sinks(sq, sk, sv, sinks)
    gates = jax.nn.sigmoid(proj[..., OFF_GATE:IN_COLS]).reshape(B, S, N_BRANCH, D_MODEL)
    merged = (gates[:, :, 0] * (y_a @ p_ret)
              + gates[:, :, 1] * (y_b @ p_conv)
              + gates[:, :, 2] * (y_c @ p_swa))
    return merged @ w_out


def setup_inputs(seed: int = 0) -> dict:
    key = jax.random.key(seed)
    ks = jax.random.split(key, 24)
    f32 = jnp.float32

    def nrm(k, shape, scale):
        return jax.random.normal(k, shape, f32) * scale

    def gain(k, shape):
        return 1.0 + 0.05 * jax.random.normal(k, shape, f32)

    Dm = D_MODEL
    return {
        'x': nrm(ks[0], (BATCH, SEQ, Dm), 1.0),
        'c': nrm(ks[1], (BATCH, Dm), 1.0),
        'ada_w': nrm(ks[2], (DEPTH, Dm, N_MOD * Dm), 0.5 * Dm ** -0.5),
        'ada_b': nrm(ks[3], (DEPTH, N_MOD * Dm), 0.02),
        'ffn1_norm': gain(ks[4], (DEPTH, Dm)),
        'ffn1_w1': nrm(ks[5], (DEPTH, Dm, D_FF), Dm ** -0.5),
        'ffn1_w3': nrm(ks[6], (DEPTH, Dm, D_FF), Dm ** -0.5),
        'ffn1_w2': nrm(ks[7], (DEPTH, D_FF, Dm), D_FF ** -0.5),
        'mix_norm': gain(ks[8], (DEPTH, Dm)),
        'w_in': nrm(ks[9], (DEPTH, Dm, IN_COLS), Dm ** -0.5),
        'conv_w': nrm(ks[10], (DEPTH, CONV_K, CONV_CH), CONV_K ** -0.5),
        'swa_sinks': nrm(ks[11], (DEPTH, SWA_Q_HEADS), 1.0),
        'p_ret': nrm(ks[12], (DEPTH, RET_WIDTH, Dm), RET_WIDTH ** -0.5),
        'p_conv': nrm(ks[13], (DEPTH, CONV_CH, Dm), CONV_CH ** -0.5),
        'p_swa': nrm(ks[14], (DEPTH, SWA_WIDTH, Dm), SWA_WIDTH ** -0.5),
        'w_out': nrm(ks[15], (DEPTH, Dm, Dm), Dm ** -0.5),
        'ffn2_norm': gain(ks[16], (DEPTH, Dm)),
        'ffn2_w1': nrm(ks[17], (DEPTH, Dm, D_FF), Dm ** -0.5),
        'ffn2_w3': nrm(ks[18], (DEPTH, Dm, D_FF), Dm ** -0.5),
        'ffn2_w2': nrm(ks[19], (DEPTH, D_FF, Dm), D_FF ** -0.5),
        'final_norm': gain(ks[20], (Dm,)),
    }


def reference(x, c, ada_w, ada_b, ffn1_norm, ffn1_w1, ffn1_w3, ffn1_w2, mix_norm, w_in,
              conv_w, swa_sinks, p_ret, p_conv, p_swa, w_out, ffn2_norm, ffn2_w1, ffn2_w3,
              ffn2_w2, final_norm):
    h = x
    c_act = jax.nn.silu(c)
    for l in range(DEPTH):
        mod = c_act @ ada_w[l] + ada_b[l]
        sh1, sc1, g1, sh2, sc2, g2, sh3, sc3, g3 = jnp.split(mod, N_MOD, axis=-1)
        u = modulate(rmsnorm(h, ffn1_norm[l]), sh1, sc1)
        h = h + MACARON_WEIGHT * g1[:, None, :] * swiglu(u, ffn1_w1[l], ffn1_w3[l], ffn1_w2[l])
        u = modulate(rmsnorm(h, mix_norm[l]), sh2, sc2)
        h = h + g2[:, None, :] * hybrid_mixer(u, w_in[l], conv_w[l], swa_sinks[l], p_ret[l],
                                              p_conv[l], p_swa[l], w_out[l])
        u = modulate(rmsnorm(h, ffn2_norm[l]), sh3, sc3)
        h = h + MACARON_WEIGHT * g3[:, None, :] * swiglu(u, ffn2_w1[l], ffn2_w3[l], ffn2_w2[l])
    return rmsnorm(h, final_norm)
```

```cpp
#include <hip/hip_runtime.h>
#include <hip/hip_cooperative_groups.h>
#include <cstdio>
#include <cstdint>
namespace cg = cooperative_groups;

#ifndef MK_ONE_LAUNCH
#define MK_ONE_LAUNCH 1
#endif

#define LAS __attribute__((address_space(3)))
typedef unsigned short bf16;
typedef short bf16x8 __attribute__((ext_vector_type(8)));
typedef short s16x4 __attribute__((ext_vector_type(4)));
typedef float f32x4 __attribute__((ext_vector_type(4)));
typedef float f32x2 __attribute__((ext_vector_type(2)));
typedef unsigned u32x4 __attribute__((ext_vector_type(4)));
typedef unsigned u32x2 __attribute__((ext_vector_type(2)));

constexpr int D = 1024, BATCH = 8, SEQ = 4096, M = BATCH * SEQ, DFF = 2816, INC = 11520, MODW = 9 * D;
constexpr float EPS = 1e-6f;
constexpr float LOG2E = 1.4426950408889634f;
constexpr size_t MiB = 1u << 20;
constexpr size_t WS_MOD = 1 * MiB;
constexpr size_t WS_ROT = 2 * MiB;
constexpr size_t WS_SSQ = 6 * MiB;
constexpr size_t WS_W = 10 * MiB;
constexpr size_t W_W13 = WS_W, W_W2 = WS_W + 11 * MiB;
constexpr size_t W_IN = WS_W, W_PCAT = WS_W + 23 * MiB, W_OUT = WS_W + 29 * MiB;
constexpr size_t WS_U = 42 * MiB;
constexpr size_t WS_BIG = 106 * MiB;
constexpr size_t PLANE = 64 * MiB;
constexpr size_t WS_Y = WS_BIG + 208 * MiB;
constexpr size_t WS_END = WS_Y + 3 * PLANE;
constexpr int LDS_BYTES = 147456;
#ifdef MK_DUP_K
constexpr int NPHASE = 32;
#else
constexpr int NPHASE = 30;
#endif
constexpr int CW_BAR = 4096;
constexpr size_t CTL_ZERO_BYTES = 65536;
constexpr int MISC_OFF = 131072 + 64;

typedef __bf16 bf16x2_t __attribute__((ext_vector_type(2)));
__device__ __forceinline__ unsigned cvt_pk_bf16(float lo, float hi) { const f32x2 v = {lo, hi}; const bf16x2_t b = __builtin_convertvector(v, bf16x2_t); return __builtin_bit_cast(unsigned, b); }
__device__ __forceinline__ float bf_lo(unsigned w) { return __uint_as_float(w << 16); }
__device__ __forceinline__ float bf_hi(unsigned w) { return __uint_as_float(w & 0xffff0000u); }
__device__ __forceinline__ float silu_f(float x) { return x * __builtin_amdgcn_rcpf(1.0f + __builtin_amdgcn_exp2f(-LOG2E * x)); }
__device__ __forceinline__ float sigmoid_f(float x) { return __builtin_amdgcn_rcpf(1.0f + __builtin_amdgcn_exp2f(-LOG2E * x)); }
__device__ __forceinline__ f32x4 mfma16(bf16x8 a, bf16x8 b, f32x4 c) { return __builtin_amdgcn_mfma_f32_16x16x32_bf16(a, b, c, 0, 0, 0); }
typedef short v4i16_t __attribute__((ext_vector_type(4)));
__device__ __forceinline__ s16x4 tr_read(LAS const unsigned char* p) { return __builtin_bit_cast(s16x4, __builtin_amdgcn_ds_read_tr16_b64_v4i16((LAS v4i16_t*)p)); }
__device__ __forceinline__ bf16x8 cat4(s16x4 lo, s16x4 hi) { return (bf16x8){lo[0], lo[1], lo[2], lo[3], hi[0], hi[1], hi[2], hi[3]}; }
#define LDS_WAIT() asm volatile("s_waitcnt lgkmcnt(0)" ::: "memory")
#define WG_BAR() do { asm volatile("s_waitcnt lgkmcnt(0)" ::: "memory"); __builtin_amdgcn_s_barrier(); asm volatile("" ::: "memory"); } while (0)
__device__ __forceinline__ float wave_sum(float v) {
#pragma unroll
    for (int o = 1; o < 64; o <<= 1) v += __shfl_xor(v, o);
    return v;
}

namespace pg8 {
constexpr int BM = 256, BK = 64, HALF = 128, HTB = HALF * BK * 2, STAGE_BYTES = 8 * HTB, NXCD = 8, WGM = 8;
__host__ __device__ __forceinline__ int lds_byte(int r, int c) { const int st = (r >> 4) * 2 + (c >> 5), rr = r & 15, cc = c & 31, ob = rr * 64 + cc * 2; return st * 1024 + (ob ^ (((ob >> 9) & 1) << 5)); }
__host__ __device__ __forceinline__ void stage_rc(int b, int& R, int& C) { const int st = b / 1024, sb = b % 1024, swz = sb ^ (((sb >> 9) & 1) << 5); R = (st >> 1) * 16 + swz / 64; C = (st & 1) * 32 + (swz % 64) / 2; }
__host__ __device__ __forceinline__ int perm32(int rho) { const int n = rho >> 4, i = rho & 15; return 8 * (i >> 2) + 4 * n + (i & 3); }

struct Unit { int pm, pn; };
struct Gemm { const bf16* A; const bf16* Bt; int M, N, K, lda, segShift; size_t segStride; };

struct StaticOrder {
    int nM, nN, nwg, G, c;
    __device__ void init(int M_, int N_, int G_, int c_) { nM = M_ / BM; nN = N_ / BM; nwg = nM * nN; G = G_; c = c_; }
    __device__ bool next(int i, Unit& u) const {
        const long L = (long)i * G + c; if (L >= nwg) return false;
        int wgid = (int)L; { const int q = nwg / NXCD, r = nwg % NXCD, xcd = wgid % NXCD, off = wgid / NXCD; wgid = (xcd < r ? xcd * (q + 1) : r * (q + 1) + (xcd - r) * q) + off; }
        const int nig = WGM * nN, gid = wgid / nig, fm = gid * WGM, gsz = (nM - fm) < WGM ? (nM - fm) : WGM;
        u.pm = fm + ((wgid % nig) % gsz); u.pn = (wgid % nig) / gsz; return true;
    }
};

typedef f32x4 Acc[2][2][4][2];

struct EpiUp {
    static constexpr bool PERM = true, HAS_MID = false;
    bf16* O; bool nop;
    __device__ __forceinline__ void mid(Acc&, const Unit&, int, int, int, int, int) const {}
    __device__ __forceinline__ void operator()(const Acc& acc, const Unit& u, int wr, int wc, int fr, int fq) const {
        if (nop) return;
        const int row0 = u.pm * BM + wr * 64 + fr, col0 = u.pn * 128 + wc * 32 + 8 * fq;
#pragma unroll
        for (int ai = 0; ai < 2; ++ai)
#pragma unroll
            for (int m = 0; m < 4; ++m) {
                bf16* rowp = O + (size_t)(row0 + ai * HALF + m * 16) * DFF + col0;
                const f32x4 a0 = acc[ai][0][m][0], a1 = acc[ai][0][m][1], b0 = acc[ai][1][m][0], b1 = acc[ai][1][m][1];
                u32x4 w;
                w.x = cvt_pk_bf16(silu_f(a0[0]) * b0[0], silu_f(a0[1]) * b0[1]); w.y = cvt_pk_bf16(silu_f(a0[2]) * b0[2], silu_f(a0[3]) * b0[3]);
                w.z = cvt_pk_bf16(silu_f(a1[0]) * b1[0], silu_f(a1[1]) * b1[1]); w.w = cvt_pk_bf16(silu_f(a1[2]) * b1[2], silu_f(a1[3]) * b1[3]);
                *(u32x4*)rowp = w;
            }
    }
};
struct EpiRes {
    static constexpr bool PERM = false, HAS_MID = false;
    const float* Hin; float* Hout; const float* gate; float coef;
    __device__ __forceinline__ void mid(Acc&, const Unit&, int, int, int, int, int) const {}
    __device__ __forceinline__ void operator()(const Acc& acc, const Unit& u, int wr, int wc, int fr, int fq) const {
        const int row0 = u.pm * BM + wr * 64 + fr, col0 = u.pn * BM + wc * 32 + 4 * fq, b = u.pm >> 4;
        f32x4 gv[2][2];
#pragma unroll
        for (int bj = 0; bj < 2; ++bj)
#pragma unroll
            for (int n = 0; n < 2; ++n) gv[bj][n] = *(const f32x4*)(gate + (size_t)b * MODW + col0 + bj * HALF + n * 16) * coef;
#pragma unroll
        for (int ai = 0; ai < 2; ++ai) {
            f32x4 h[4][2][2];
#pragma unroll
            for (int m = 0; m < 4; ++m) { const size_t off = (size_t)(row0 + ai * HALF + m * 16) * D + col0;
#pragma unroll
                for (int bj = 0; bj < 2; ++bj)
#pragma unroll
                    for (int n = 0; n < 2; ++n) h[m][bj][n] = *(const f32x4*)(Hin + off + bj * HALF + n * 16); }
            asm volatile("" ::: "memory");
#pragma unroll
            for (int m = 0; m < 4; ++m) { const size_t off = (size_t)(row0 + ai * HALF + m * 16) * D + col0;
#pragma unroll
                for (int bj = 0; bj < 2; ++bj)
#pragma unroll
                    for (int n = 0; n < 2; ++n) *(f32x4*)(Hout + off + bj * HALF + n * 16) = h[m][bj][n] + gv[bj][n] * acc[ai][bj][m][n]; }
            asm volatile("" ::: "memory");
        }
    }
};
struct EpiProj {
    static constexpr bool PERM = true, HAS_MID = false;
    unsigned char* big; int grp; const float* rot;
    __device__ __forceinline__ void mid(Acc&, const Unit&, int, int, int, int, int) const {}
    __device__ __forceinline__ void operator()(const Acc& acc, const Unit& u, int wr, int wc, int fr, int fq) const {
        int mode, plane, colt, ldc = D; float sc = 1.f; const int pn = u.pn;
        if (grp == 0) { plane = pn >> 2; colt = (pn & 3) * 256; mode = plane < 2 ? 1 : (plane == 2 ? 0 : 2); sc = plane == 1 ? 0.0625f : 1.f; }
        else if (grp == 1) {
            if (pn < 4) { plane = 0; colt = 256 * pn; mode = 0; }
            else if (pn < 12) { plane = 1; colt = 128 * (pn - 4); mode = 4; }
            else if (pn < 16) { plane = 2; colt = 256 * (pn - 12); mode = 0; sc = 0.125f; }
            else { plane = 3; colt = 0; mode = 0; ldc = 256; }
        } else { plane = pn >> 2; colt = (pn & 3) * 256; mode = 3; }
        bf16* O = (grp == 0 && plane == 3) ? (bf16*)(big + 208 * MiB) : (bf16*)(big + (size_t)plane * PLANE);
        const int row0 = u.pm * BM + wr * 64 + fr, cl = wc * 32 + 8 * fq;
        if (mode == 4) {
#pragma unroll
            for (int ai = 0; ai < 2; ++ai)
#pragma unroll
                for (int m = 0; m < 4; ++m) {
                    const f32x4 v0 = acc[ai][0][m][0] * acc[ai][1][m][0], v1 = acc[ai][0][m][1] * acc[ai][1][m][1];
                    u32x4 w; w.x = cvt_pk_bf16(v0[0], v0[1]); w.y = cvt_pk_bf16(v0[2], v0[3]); w.z = cvt_pk_bf16(v1[0], v1[1]); w.w = cvt_pk_bf16(v1[2], v1[3]);
                    *(u32x4*)(O + (size_t)(row0 + ai * HALF + m * 16) * D + colt + cl) = w;
                }
        } else if (mode == 1) {
#pragma unroll
            for (int ai = 0; ai < 2; ++ai) {
                f32x4 cs[4][4];
#pragma unroll
                for (int m = 0; m < 4; ++m) { const int pos = (row0 + ai * HALF + m * 16) & (SEQ - 1); const f32x4* rp = (const f32x4*)(rot + ((size_t)pos * 128 + cl) * 2);
#pragma unroll
                    for (int q = 0; q < 4; ++q) cs[m][q] = rp[q]; }
                asm volatile("" ::: "memory");
#pragma unroll
                for (int m = 0; m < 4; ++m) {
                    const int row = row0 + ai * HALF + m * 16;
                    const f32x4 c0 = cs[m][0], c1 = cs[m][1], c2 = cs[m][2], c3 = cs[m][3];
                    const f32x4 t1a = acc[ai][0][m][0], t1b = acc[ai][0][m][1], t2a = acc[ai][1][m][0], t2b = acc[ai][1][m][1];
                    u32x4 w1, w2;
                    w1.x = cvt_pk_bf16((t1a[0] * c0[0] - t2a[0] * c0[1]) * sc, (t1a[1] * c0[2] - t2a[1] * c0[3]) * sc);
                    w1.y = cvt_pk_bf16((t1a[2] * c1[0] - t2a[2] * c1[1]) * sc, (t1a[3] * c1[2] - t2a[3] * c1[3]) * sc);
                    w1.z = cvt_pk_bf16((t1b[0] * c2[0] - t2b[0] * c2[1]) * sc, (t1b[1] * c2[2] - t2b[1] * c2[3]) * sc);
                    w1.w = cvt_pk_bf16((t1b[2] * c3[0] - t2b[2] * c3[1]) * sc, (t1b[3] * c3[2] - t2b[3] * c3[3]) * sc);
                    w2.x = cvt_pk_bf16((t2a[0] * c0[0] + t1a[0] * c0[1]) * sc, (t2a[1] * c0[2] + t1a[1] * c0[3]) * sc);
                    w2.y = cvt_pk_bf16((t2a[2] * c1[0] + t1a[2] * c1[1]) * sc, (t2a[3] * c1[2] + t1a[3] * c1[3]) * sc);
                    w2.z = cvt_pk_bf16((t2b[0] * c2[0] + t1b[0] * c2[1]) * sc, (t2b[1] * c2[2] + t1b[1] * c2[3]) * sc);
                    w2.w = cvt_pk_bf16((t2b[2] * c3[0] + t1b[2] * c3[1]) * sc, (t2b[3] * c3[2] + t1b[3] * c3[3]) * sc);
                    bf16* rowp = O + (size_t)row * D + colt + cl;
                    *(u32x4*)rowp = w1; *(u32x4*)(rowp + HALF) = w2;
                }
                asm volatile("" ::: "memory");
            }
        } else {
#pragma unroll
            for (int ai = 0; ai < 2; ++ai)
#pragma unroll
                for (int m = 0; m < 4; ++m) {
                    bf16* rowp = O + (size_t)(row0 + ai * HALF + m * 16) * ldc + colt + cl;
#pragma unroll
                    for (int bj = 0; bj < 2; ++bj) {
                        f32x4 v0 = acc[ai][bj][m][0], v1 = acc[ai][bj][m][1];
                        if (mode == 0) { v0 = v0 * sc; v1 = v1 * sc; }
                        else if (mode == 2) {
#pragma unroll
                            for (int j = 0; j < 4; ++j) { v0[j] = silu_f(v0[j]); v1[j] = silu_f(v1[j]); } }
                        else {
#pragma unroll
                            for (int j = 0; j < 4; ++j) { v0[j] = sigmoid_f(v0[j]); v1[j] = sigmoid_f(v1[j]); } }
                        u32x4 w; w.x = cvt_pk_bf16(v0[0], v0[1]); w.y = cvt_pk_bf16(v0[2], v0[3]); w.z = cvt_pk_bf16(v1[0], v1[1]); w.w = cvt_pk_bf16(v1[2], v1[3]);
                        *(u32x4*)(rowp + bj * HALF) = w;
                    }
                }
        }
    }
};
struct EpiMerge {
    static constexpr bool PERM = true, HAS_MID = true;
    const bf16* gates;
    bf16* O;
    __device__ __forceinline__ void ld8(int plane, size_t off, f32x4& lo, f32x4& hi) const {
        const u32x4 w = *(const u32x4*)(gates + (size_t)plane * (PLANE / 2) + off);
        lo = (f32x4){bf_lo(w.x), bf_hi(w.x), bf_lo(w.y), bf_hi(w.y)}; hi = (f32x4){bf_lo(w.z), bf_hi(w.z), bf_lo(w.w), bf_hi(w.w)};
    }
    __device__ __forceinline__ u32x4 ldg(int plane, size_t off) const { return *(const u32x4*)(gates + (size_t)plane * (PLANE / 2) + off); }
    static __device__ __forceinline__ void unpack(const u32x4 w, f32x4& lo, f32x4& hi) {
        lo = (f32x4){bf_lo(w.x), bf_hi(w.x), bf_lo(w.y), bf_hi(w.y)}; hi = (f32x4){bf_lo(w.z), bf_hi(w.z), bf_lo(w.w), bf_hi(w.w)}; }
    __device__ __forceinline__ void mid(Acc& acc, const Unit& u, int which, int wr, int wc, int fr, int fq) const {
        const int pnum = which == 1 ? 1 : 2, pden = which == 1 ? 2 : 0;
        const int row0 = u.pm * BM + wr * 64 + fr, col0 = u.pn * BM + wc * 32 + 8 * fq;
#pragma unroll
        for (int ai = 0; ai < 2; ++ai) {
            u32x4 wn[4][2], wd[4][2];
#pragma unroll
            for (int m = 0; m < 4; ++m) { const size_t off = (size_t)(row0 + ai * HALF + m * 16) * D + col0;
#pragma unroll
                for (int bj = 0; bj < 2; ++bj) { wn[m][bj] = ldg(pnum, off + bj * HALF); wd[m][bj] = ldg(pden, off + bj * HALF); } }
            asm volatile("" ::: "memory");
#pragma unroll
            for (int m = 0; m < 4; ++m)
#pragma unroll
                for (int bj = 0; bj < 2; ++bj) {
                    f32x4 nl, nh, dl, dh; unpack(wn[m][bj], nl, nh); unpack(wd[m][bj], dl, dh);
#pragma unroll
                    for (int j = 0; j < 4; ++j) { acc[ai][bj][m][0][j] *= nl[j] * __builtin_amdgcn_rcpf(dl[j]); acc[ai][bj][m][1][j] *= nh[j] * __builtin_amdgcn_rcpf(dh[j]); }
                }
            asm volatile("" ::: "memory");
        }
    }
    __device__ __forceinline__ void operator()(const Acc& acc, const Unit& u, int wr, int wc, int fr, int fq) const {
        const int row0 = u.pm * BM + wr * 64 + fr, col0 = u.pn * BM + wc * 32 + 8 * fq;
#pragma unroll
        for (int ai = 0; ai < 2; ++ai) {
            u32x4 wg[4][2];
#pragma unroll
            for (int m = 0; m < 4; ++m) { const size_t off = (size_t)(row0 + ai * HALF + m * 16) * D + col0;
#pragma unroll
                for (int bj = 0; bj < 2; ++bj) wg[m][bj] = ldg(0, off + bj * HALF); }
            asm volatile("" ::: "memory");
#pragma unroll
            for (int m = 0; m < 4; ++m) { const size_t off = (size_t)(row0 + ai * HALF + m * 16) * D + col0;
#pragma unroll
                for (int bj = 0; bj < 2; ++bj) {
                    f32x4 gl, gh; unpack(wg[m][bj], gl, gh);
                    const f32x4 v0 = acc[ai][bj][m][0] * gl, v1 = acc[ai][bj][m][1] * gh;
                    u32x4 w; w.x = cvt_pk_bf16(v0[0], v0[1]); w.y = cvt_pk_bf16(v0[2], v0[3]); w.z = cvt_pk_bf16(v1[0], v1[1]); w.w = cvt_pk_bf16(v1[2], v1[3]);
                    *(u32x4*)(O + off + bj * HALF) = w;
                } }
            asm volatile("" ::: "memory");
        }
    }
};

template <class Epi>
__device__ __forceinline__ void gemm_phase(LAS unsigned char* lds, const Gemm g, const StaticOrder& S, const Epi& E, const int tid) {
    const int wid = __builtin_amdgcn_readfirstlane(tid >> 6), lane = tid & 63, wr = wid >> 2, wc = wid & 3, fr = lane & 15, fq = lane >> 4;
    const int K = g.K, nt = K / BK, lda = g.lda, segMask = (1 << g.segShift) - 1;
    unsigned voffA[2], voffB[2];
#pragma unroll
    for (int i = 0; i < 2; ++i) { int R, C; stage_rc(tid * 16 + i * 8192, R, C); const int Rb = Epi::PERM ? ((R & ~31) + perm32(R & 31)) : R;
        voffA[i] = (unsigned)(R * lda + C) * 2u; voffB[i] = (unsigned)(Rb * K + C) * 2u; }
    const size_t kstep = (size_t)(BK * 2);
    const size_t hstepA = (size_t)HALF * lda * 2, tstepA = 2 * hstepA;
    const size_t hstepB = (size_t)HALF * K * 2, tstepB = 2 * hstepB;
    const unsigned ldsw = (unsigned)wid * 1024u;
    const int aoff = lds_byte(wr * 64 + fr, fq * 8), boff = lds_byte(wc * 32 + fr, fq * 8);
#define PG8_KOFFA(t) ((size_t)((t) >> g.segShift) * g.segStride + (size_t)((t) & segMask) * kstep)
#define PG8_SA(b, h) (((b) * 2 + (h)) * HTB)
#define PG8_SB(b, h) ((4 + (b) * 2 + (h)) * HTB)
#define PG8_STAGE(bufoff, gbase, voff) do { _Pragma("unroll") for (int _i = 0; _i < 2; ++_i) \
        __builtin_amdgcn_global_load_lds((const unsigned*)((const char*)(gbase) + (voff)[_i]), (LAS unsigned*)(lds + (bufoff) + ldsw + _i * 8192), 16, 0, 0); } while (0)
#define PG8_LDA(dst, b, h) do { _Pragma("unroll") for (int m = 0; m < 4; ++m) _Pragma("unroll") for (int k = 0; k < 2; ++k) dst[m][k] = *(const LAS bf16x8*)(lds + PG8_SA(b, h) + aoff + m * 2048 + k * 1024); } while (0)
#define PG8_LDB(dst, b, h) do { _Pragma("unroll") for (int n = 0; n < 2; ++n) _Pragma("unroll") for (int k = 0; k < 2; ++k) dst[n][k] = *(const LAS bf16x8*)(lds + PG8_SB(b, h) + boff + n * 2048 + k * 1024); } while (0)
#define PG8_MMA(ai, bj, At, Bt) do { __builtin_amdgcn_s_setprio(1); _Pragma("unroll") for (int m = 0; m < 4; ++m) _Pragma("unroll") for (int n = 0; n < 2; ++n) _Pragma("unroll") for (int k = 0; k < 2; ++k) \
        acc[ai][bj][m][n] = __builtin_amdgcn_mfma_f32_16x16x32_bf16(Bt[n][k], At[m][k], acc[ai][bj][m][n], 0, 0, 0); __builtin_amdgcn_s_setprio(0); } while (0)
#define PG8_WAIT_V(n) asm volatile("s_waitcnt vmcnt(" #n ")" ::: "memory")
#define PG8_WAIT_L(n) asm volatile("s_waitcnt lgkmcnt(" #n ")" ::: "memory")
#define PG8_BAR __builtin_amdgcn_s_barrier()
#define PG8_SCHED __builtin_amdgcn_sched_barrier(0)
    Unit cur, nxt; int ui = 0;
    if (!S.next(0, cur)) return;
    Acc acc;
#pragma unroll
    for (int a = 0; a < 2; ++a)
#pragma unroll
        for (int b = 0; b < 2; ++b)
#pragma unroll
            for (int m = 0; m < 4; ++m)
#pragma unroll
                for (int n = 0; n < 2; ++n) acc[a][b][m][n] = (f32x4){0.f, 0.f, 0.f, 0.f};
    bf16x8 At[4][2], B0[2][2], B1[2][2];
    const char* cA = (const char*)g.A + (size_t)cur.pm * tstepA; const char* cB = (const char*)g.Bt + (size_t)cur.pn * tstepB;
    PG8_STAGE(PG8_SB(0, 0), cB, voffB); PG8_STAGE(PG8_SB(0, 1), cB + hstepB, voffB); PG8_STAGE(PG8_SA(0, 0), cA, voffA); PG8_STAGE(PG8_SA(0, 1), cA + hstepA, voffA);
    if (wr == 1) PG8_BAR;
    PG8_WAIT_V(2); PG8_BAR;
    PG8_STAGE(PG8_SB(1, 0), cB + kstep, voffB); PG8_STAGE(PG8_SA(1, 0), cA + kstep, voffA); PG8_STAGE(PG8_SB(1, 1), cB + hstepB + kstep, voffB);
    PG8_WAIT_V(6); PG8_BAR;
    for (;;) {
        const bool has_next = S.next(ui + 1, nxt);
        const char* nA = has_next ? (const char*)g.A + (size_t)nxt.pm * tstepA : cA; const char* nB = has_next ? (const char*)g.Bt + (size_t)nxt.pn * tstepB : cB;
        for (int t = 0; t < nt; t += 2) {
            const bool last = (t == nt - 2);
            const char* a1 = cA + PG8_KOFFA(t + 1);
            const char* a2 = last ? nA : cA + PG8_KOFFA(t + 2); const char* b2 = last ? nB : cB + (size_t)(t + 2) * kstep;
            const char* a3 = a2 + kstep; const char* b3 = b2 + kstep;
            PG8_LDB(B0, 0, 0); PG8_LDB(B1, 0, 1); PG8_SCHED; PG8_LDA(At, 0, 0); PG8_STAGE(PG8_SA(1, 1), a1 + hstepA, voffA);
            PG8_WAIT_V(8); PG8_WAIT_L(0); PG8_BAR; PG8_MMA(0, 0, At, B0); PG8_MMA(0, 1, At, B1); PG8_BAR; PG8_SCHED;
            PG8_LDA(At, 0, 1); PG8_STAGE(PG8_SB(0, 0), b2, voffB); PG8_STAGE(PG8_SB(0, 1), b2 + hstepB, voffB); PG8_STAGE(PG8_SA(0, 0), a2, voffA);
            PG8_WAIT_V(8); PG8_WAIT_L(0); PG8_BAR; PG8_MMA(1, 0, At, B0); PG8_MMA(1, 1, At, B1); PG8_BAR; PG8_SCHED;
            PG8_LDB(B0, 1, 0); PG8_LDB(B1, 1, 1); PG8_SCHED; PG8_LDA(At, 1, 0); PG8_STAGE(PG8_SA(0, 1), a2 + hstepA, voffA);
            PG8_WAIT_V(8); PG8_WAIT_L(0); PG8_BAR; PG8_MMA(0, 0, At, B0); PG8_MMA(0, 1, At, B1); PG8_BAR; PG8_SCHED;
            PG8_LDA(At, 1, 1); PG8_STAGE(PG8_SB(1, 0), b3, voffB); PG8_STAGE(PG8_SB(1, 1), b3 + hstepB, voffB); PG8_STAGE(PG8_SA(1, 0), a3, voffA);
            PG8_WAIT_V(8); PG8_WAIT_L(0); PG8_BAR; PG8_MMA(1, 0, At, B0); PG8_MMA(1, 1, At, B1); PG8_BAR; PG8_SCHED;
            if constexpr (Epi::HAS_MID) { if (!last && ((t + 2) & 15) == 0) { int fr_ = fr, fq_ = fq; asm volatile("" : "+v"(fr_), "+v"(fq_)); E.mid(acc, cur, (t + 2) >> 4, wr, wc, fr_, fq_); PG8_SCHED; } }
        }
        if (wr == 0) PG8_BAR;
        { int fr_ = fr, fq_ = fq; asm volatile("" : "+v"(fr_), "+v"(fq_)); E(acc, cur, wr, wc, fr_, fq_); }
        if (!has_next) break;
#pragma unroll
        for (int a = 0; a < 2; ++a)
#pragma unroll
            for (int b = 0; b < 2; ++b)
#pragma unroll
                for (int m = 0; m < 4; ++m)
#pragma unroll
                    for (int n = 0; n < 2; ++n) acc[a][b][m][n] = (f32x4){0.f, 0.f, 0.f, 0.f};
        cur = nxt; cA = nA; cB = nB; ++ui;
        if (wr == 1) PG8_BAR;
    }
    PG8_WAIT_V(0);
    PG8_BAR;
#undef PG8_KOFFA
#undef PG8_SA
#undef PG8_SB
#undef PG8_STAGE
#undef PG8_LDA
#undef PG8_LDB
#undef PG8_MMA
#undef PG8_WAIT_V
#undef PG8_WAIT_L
#undef PG8_BAR
#undef PG8_SCHED
}
}

__device__ __forceinline__ void transpose_item(const float* W, int N, int k0, int n0, bf16* WT, int Kd, int drow0, int dcol0, LAS float* scr, int lane) {
    float tv[32];
#pragma unroll
    for (int i = 0; i < 32; ++i) { const int kk = 2 * i + (lane >> 5); tv[i] = W[(size_t)(k0 + kk) * N + n0 + (lane & 31)]; }
#pragma unroll
    for (int i = 0; i < 32; ++i) { const int kk = 2 * i + (lane >> 5); scr[kk * 33 + (lane & 31)] = tv[i]; }
    if (0) for (int i = 0; i < 32; ++i) { const int kk = 2 * i + (lane >> 5); scr[kk * 33 + (lane & 31)] = W[(size_t)(k0 + kk) * N + n0 + (lane & 31)]; }
    LDS_WAIT();
    const int c = lane & 7;
#pragma unroll
    for (int j = 0; j < 4; ++j) { const int n = (lane >> 3) + 8 * j; const LAS float* s = scr + (8 * c) * 33 + n;
        u32x4 o; o.x = cvt_pk_bf16(s[0 * 33], s[1 * 33]); o.y = cvt_pk_bf16(s[2 * 33], s[3 * 33]); o.z = cvt_pk_bf16(s[4 * 33], s[5 * 33]); o.w = cvt_pk_bf16(s[6 * 33], s[7 * 33]);
        *(u32x4*)(WT + (size_t)(drow0 + n) * Kd + dcol0 + k0 + 8 * c) = o; }
    LDS_WAIT();
}
__device__ __forceinline__ void convert_ffn(const float* w1, const float* w3, const float* w2, unsigned char* ws, LAS float* scr, int gw, int ngw, int lane) {
    bf16* W13 = (bf16*)(ws + W_W13); bf16* W2 = (bf16*)(ws + W_W2);
    for (int it = gw; it < 4224; it += ngw) {
        if (it < 2816) { const int sel = it >= 1408, r = it - sel * 1408, kb = r / 88, nb = r % 88, n0 = 32 * nb;
            transpose_item(sel ? w3 : w1, DFF, 64 * kb, n0, W13, D, 256 * (n0 >> 7) + 128 * sel + (n0 & 127), 0, scr, lane); }
        else { const int r = it - 2816, kb = r / 32, nb = r % 32; transpose_item(w2, D, 64 * kb, 32 * nb, W2, DFF, 32 * nb, 0, scr, lane); }
    }
}
__device__ __forceinline__ void convert_mixer(const float* w_in, const float* p_ret, const float* p_conv, const float* p_swa, const float* w_out, unsigned char* ws, LAS float* scr, int gw, int ngw, int lane) {
    bf16* WIN = (bf16*)(ws + W_IN); bf16* PC = (bf16*)(ws + W_PCAT); bf16* WO = (bf16*)(ws + W_OUT);
    for (int it = gw; it < 7808; it += ngw) {
        if (it < 5760) { const int kb = it / 360, nb = it % 360, n0 = 32 * nb; int dr = n0;
            if (n0 >= 5120 && n0 < 6144) { const int ch = n0 - 5120; dr = 5120 + 256 * (ch >> 7) + (ch & 127); }
            else if (n0 >= 6144 && n0 < 7168) { const int ch = n0 - 6144; dr = 5120 + 256 * (ch >> 7) + 128 + (ch & 127); }
            transpose_item(w_in, INC, 64 * kb, n0, WIN, D, dr, 0, scr, lane); }
        else if (it < 7296) { const int r = it - 5760, sel = r / 512, q = r % 512, kb = q / 32, nb = q % 32;
            transpose_item(sel == 0 ? p_conv : (sel == 1 ? p_swa : p_ret), D, 64 * kb, 32 * nb, PC, 3 * D, 32 * nb, sel * D, scr, lane); }
        else { const int q = it - 7296, kb = q / 32, nb = q % 32; transpose_item(w_out, D, 64 * kb, 32 * nb, WO, D, 32 * nb, 0, scr, lane); }
    }
}
__device__ __forceinline__ void norm_rows(const float* hin, const float* gain, const float* sh, const float* sc, bf16* U, int gw, int ngw, int lane) {
    for (int blk = gw; blk < M / 16; blk += ngw) {
        const int r0 = blk * 16, b = r0 >> 12;
        f32x4 gm[4], sv[4];
#pragma unroll
        for (int j = 0; j < 4; ++j) { const int col = 4 * (64 * j + lane); const f32x4 g4 = *(const f32x4*)(gain + col), s4 = *(const f32x4*)(sc + (size_t)b * MODW + col);
            gm[j] = g4 * (s4 + 1.0f); sv[j] = *(const f32x4*)(sh + (size_t)b * MODW + col); }
        for (int r = r0; r < r0 + 16; r += 4) {
            f32x4 v[4][4]; float s[4];
#pragma unroll
            for (int q = 0; q < 4; ++q) { const f32x4* xr = (const f32x4*)(hin + (size_t)(r + q) * D) + lane;
#pragma unroll
                for (int j = 0; j < 4; ++j) v[q][j] = xr[64 * j]; }
#pragma unroll
            for (int q = 0; q < 4; ++q) { s[q] = 0.f;
#pragma unroll
                for (int j = 0; j < 4; ++j) s[q] += (v[q][j][0] * v[q][j][0] + v[q][j][1] * v[q][j][1]) + (v[q][j][2] * v[q][j][2] + v[q][j][3] * v[q][j][3]); }
#pragma unroll
            for (int o = 1; o < 64; o <<= 1) {
#pragma unroll
                for (int q = 0; q < 4; ++q) s[q] += __shfl_xor(s[q], o); }
#pragma unroll
            for (int q = 0; q < 4; ++q) { const float rstd = 1.0f / sqrtf(s[q] * (1.0f / D) + EPS);
                u32x2* o8 = (u32x2*)(U + (size_t)(r + q) * D) + lane;
#pragma unroll
                for (int j = 0; j < 4; ++j) { const f32x4 y = v[q][j] * rstd * gm[j] + sv[j]; u32x2 w; w.x = cvt_pk_bf16(y[0], y[1]); w.y = cvt_pk_bf16(y[2], y[3]); o8[64 * j] = w; } }
        }
    }
}
__device__ __forceinline__ void final_norm_rows(float* h, const float* gain, int gw, int ngw, int lane) {
    f32x4 gm[4];
#pragma unroll
    for (int j = 0; j < 4; ++j) gm[j] = *(const f32x4*)(gain + 4 * (64 * j + lane));
    for (int r0 = gw * 4; r0 < M; r0 += ngw * 4) {
        f32x4 v[4][4]; float s[4];
#pragma unroll
        for (int q = 0; q < 4; ++q) { const f32x4* xr = (const f32x4*)(h + (size_t)(r0 + q) * D) + lane;
#pragma unroll
            for (int j = 0; j < 4; ++j) v[q][j] = xr[64 * j]; }
#pragma unroll
        for (int q = 0; q < 4; ++q) { s[q] = 0.f;
#pragma unroll
            for (int j = 0; j < 4; ++j) s[q] += (v[q][j][0] * v[q][j][0] + v[q][j][1] * v[q][j][1]) + (v[q][j][2] * v[q][j][2] + v[q][j][3] * v[q][j][3]); }
#pragma unroll
        for (int o = 1; o < 64; o <<= 1) {
#pragma unroll
            for (int q = 0; q < 4; ++q) s[q] += __shfl_xor(s[q], o); }
#pragma unroll
        for (int q = 0; q < 4; ++q) { const float rstd = 1.0f / sqrtf(s[q] * (1.0f / D) + EPS); f32x4* xw = (f32x4*)(h + (size_t)(r0 + q) * D) + lane;
#pragma unroll
            for (int j = 0; j < 4; ++j) xw[64 * j] = v[q][j] * rstd * gm[j]; }
    }
}
__device__ __forceinline__ void p0_phase(LAS unsigned char* lds, const float* c, const float* ada_w, const float* ada_b, unsigned char* ws, int vcu, int G, int tid, int lane, int wave) {
    LAS float* cact = (LAS float*)lds; LAS float* red = (LAS float*)(lds + 32768);
    for (int i = tid; i < BATCH * D; i += 512) cact[i] = silu_f(c[i]);
    WG_BAR();
    float* mod = (float*)(ws + WS_MOD);
    for (int item = vcu; item < 288; item += G) {
        const int l = item / 144, cb = item % 144;
        const float* W = ada_w + (size_t)l * D * MODW + 64 * cb + lane;
        float a[8];
#pragma unroll
        for (int b = 0; b < 8; ++b) a[b] = 0.f;
#pragma unroll 32
        for (int k = 128 * wave; k < 128 * wave + 128; ++k) { const float w = W[(size_t)k * MODW];
#pragma unroll
            for (int b = 0; b < 8; ++b) a[b] += cact[b * D + k] * w; }
#pragma unroll
        for (int b = 0; b < 8; ++b) red[(wave * 8 + b) * 64 + lane] = a[b];
        WG_BAR();
        { const int b = wave; float s = ada_b[(size_t)l * MODW + 64 * cb + lane];
#pragma unroll
            for (int wv = 0; wv < 8; ++wv) s += red[(wv * 8 + b) * 64 + lane];
            mod[((size_t)l * 8 + b) * MODW + 64 * cb + lane] = s; }
        WG_BAR();
    }
    f32x2* rot = (f32x2*)(ws + WS_ROT);
    for (int e = vcu * 512 + tid; e < SEQ * 128; e += G * 512) {
        const int pos = e >> 7, j = e & 127;
        const float lin = (float)j / 127.0f;
        const float inv = exp2f(-lin * 13.287712379549449f);
        const float ang = (float)pos * inv;
        float sn, cs; sincosf(ang, &sn, &cs);
        rot[e] = (f32x2){cs, sn};
    }
}

__device__ __forceinline__ void scan_phase(LAS unsigned char* lds, const bf16* RQ, const bf16* RK, const bf16* RV, bf16* RO, float* ssq, int vcu, int tid, int lane, int wave, const int pmode = 0) {
    constexpr int KROW = 528, VROW = 80, SROW = 528;
    LAS unsigned char* Ks = lds; LAS unsigned char* Vs = lds + 67584; LAS unsigned char* Vzs = Vs + 10240; LAS unsigned char* Ss0 = Vzs + 10240; LAS unsigned char* Ss1 = Ss0 + 16896;
    const int p = vcu >> 3, s = vcu & 7, b = p >> 2, h = p & 3;
    const int g = lane >> 4, c16 = lane & 15, q4 = (lane >> 2) & 3, p4 = lane & 3;
    const float lg = log2f(1.0f - exp2f(-5.0f - (float)h));
    const size_t tokbase = (size_t)b * SEQ;
    for (int i = tid; i < 16896 / 4; i += 512) ((LAS unsigned*)Ss0)[i] = 0u;
    f32x4 accS[2][2];
#pragma unroll
    for (int a = 0; a < 2; ++a)
#pragma unroll
        for (int c = 0; c < 2; ++c) accS[a][c] = (f32x4){0.f, 0.f, 0.f, 0.f};
    u32x4 kreg[8]; u32x4 vreg; bf16x8 qn[8];
    const int vrow = tid >> 2, vc16 = tid & 3;
#define SCAN_LOAD(n) do { const size_t t0_ = tokbase + (size_t)(n) * 128; \
        _Pragma("unroll") for (int i_ = 0; i_ < 8; ++i_) { const int c_ = tid + 512 * i_; kreg[i_] = *(const u32x4*)(RK + (t0_ + (c_ >> 5)) * D + 256 * h + (c_ & 31) * 8); } \
        vreg = *(const u32x4*)(RV + (t0_ + vrow) * D + 256 * h + 32 * s + vc16 * 8); \
        _Pragma("unroll") for (int ks_ = 0; ks_ < 8; ++ks_) qn[ks_] = *(const bf16x8*)(RQ + (t0_ + 16 * wave + c16) * D + 256 * h + 32 * ks_ + 8 * g); } while (0)
    SCAN_LOAD(0);
    int cur = 0;
    for (int n = 0; n < 32; ++n) {
        WG_BAR();
#pragma unroll
        for (int i = 0; i < 8; ++i) { const int c = tid + 512 * i; *(LAS u32x4*)(Ks + (c >> 5) * KROW + (c & 31) * 16) = kreg[i]; }
        *(LAS u32x4*)(Vs + vrow * VROW + vc16 * 16) = vreg;
        { const float z = __builtin_amdgcn_exp2f(lg * (float)(127 - vrow)); u32x4 w;
            w.x = cvt_pk_bf16(bf_lo(vreg.x) * z, bf_hi(vreg.x) * z); w.y = cvt_pk_bf16(bf_lo(vreg.y) * z, bf_hi(vreg.y) * z);
            w.z = cvt_pk_bf16(bf_lo(vreg.z) * z, bf_hi(vreg.z) * z); w.w = cvt_pk_bf16(bf_lo(vreg.w) * z, bf_hi(vreg.w) * z);
            *(LAS u32x4*)(Vzs + vrow * VROW + vc16 * 16) = w; }
        bf16x8 qc[8];
#pragma unroll
        for (int ks = 0; ks < 8; ++ks) qc[ks] = qn[ks];
        const size_t tok0 = tokbase + (size_t)n * 128;
        if (n + 1 < 32 && !(pmode & 1)) SCAN_LOAD(n + 1);
        WG_BAR();
        LAS unsigned char* Sc = cur ? Ss1 : Ss0; LAS unsigned char* Sn = cur ? Ss0 : Ss1;
        const int i_loc = 16 * wave + c16;
        f32x4 accX[2], accI[2];
#pragma unroll
        for (int mt = 0; mt < 2; ++mt) { accX[mt] = (f32x4){0.f, 0.f, 0.f, 0.f}; accI[mt] = (f32x4){0.f, 0.f, 0.f, 0.f}; }
        {
#pragma unroll
            for (int kh = 0; kh < 4; ++kh) {
                bf16x8 fa[4];
#pragma unroll
                for (int k4 = 0; k4 < 2; ++k4)
#pragma unroll
                    for (int mt = 0; mt < 2; ++mt) fa[2 * k4 + mt] = *(const LAS bf16x8*)(Sc + (16 * mt + c16) * SROW + (32 * (2 * kh + k4) + 8 * g) * 2);
                asm volatile("" ::: "memory");
#pragma unroll
                for (int k4 = 0; k4 < 2; ++k4)
#pragma unroll
                    for (int mt = 0; mt < 2; ++mt) accX[mt] = mfma16(fa[2 * k4 + mt], qc[2 * kh + k4], accX[mt]);
            }
        }
        const int nkb = (pmode & 2) ? 0 : (wave >> 1) + 1;
        for (int kb = 0; kb < nkb; ++kb) {
            f32x4 st[2]; s16x4 vlo[2], vhi[2];
#pragma unroll
            for (int t = 0; t < 2; ++t) st[t] = (f32x4){0.f, 0.f, 0.f, 0.f};
#pragma unroll
            for (int kh = 0; kh < 4; ++kh) {
                bf16x8 fk[4];
#pragma unroll
                for (int k4 = 0; k4 < 2; ++k4)
#pragma unroll
                    for (int t = 0; t < 2; ++t) fk[2 * k4 + t] = *(const LAS bf16x8*)(Ks + (16 * (2 * kb + t) + c16) * KROW + (32 * (2 * kh + k4) + 8 * g) * 2);
                asm volatile("" ::: "memory");
#pragma unroll
                for (int k4 = 0; k4 < 2; ++k4)
#pragma unroll
                    for (int t = 0; t < 2; ++t) st[t] = mfma16(fk[2 * k4 + t], qc[2 * kh + k4], st[t]);
            }
            float pv[2][4];
#pragma unroll
            for (int t = 0; t < 2; ++t)
#pragma unroll
                for (int r = 0; r < 4; ++r) { const int d = i_loc - (16 * (2 * kb + t) + 4 * g + r); pv[t][r] = d >= 0 ? st[t][r] * __builtin_amdgcn_exp2f(lg * (float)d) : 0.f; }
            u32x4 pw; pw.x = cvt_pk_bf16(pv[0][0], pv[0][1]); pw.y = cvt_pk_bf16(pv[0][2], pv[0][3]); pw.z = cvt_pk_bf16(pv[1][0], pv[1][1]); pw.w = cvt_pk_bf16(pv[1][2], pv[1][3]);
            const bf16x8 pb = __builtin_bit_cast(bf16x8, pw);
#pragma unroll
            for (int mt = 0; mt < 2; ++mt) { vlo[mt] = tr_read(Vs + (32 * kb + 4 * g + q4) * VROW + (16 * mt + 4 * p4) * 2); vhi[mt] = tr_read(Vs + (32 * kb + 16 + 4 * g + q4) * VROW + (16 * mt + 4 * p4) * 2); }
#pragma unroll
            for (int mt = 0; mt < 2; ++mt) accI[mt] = mfma16(cat4(vlo[mt], vhi[mt]), pb, accI[mt]);
        }
        {
            const float xi = __builtin_amdgcn_exp2f(lg * (float)(i_loc + 1)); float ss = 0.f;
#pragma unroll
            for (int mt = 0; mt < 2; ++mt) { const f32x4 o = accI[mt] + accX[mt] * xi; ss += (o[0] * o[0] + o[1] * o[1]) + (o[2] * o[2] + o[3] * o[3]);
                u32x2 w; w.x = cvt_pk_bf16(o[0], o[1]); w.y = cvt_pk_bf16(o[2], o[3]);
                *(u32x2*)(RO + (tok0 + i_loc) * D + 256 * h + 32 * s + 16 * mt + 4 * g) = w; }
            ss += __shfl_xor(ss, 16); ss += __shfl_xor(ss, 32);
            if (g == 0 && pmode == 0) ssq[((tok0 + i_loc) * 4 + h) * 8 + s] = ss;
        }
        {
            const float decay = __builtin_amdgcn_exp2f(lg * 128.0f);
#pragma unroll
            for (int mt = 0; mt < 2; ++mt)
#pragma unroll
                for (int nt = 0; nt < 2; ++nt) accS[mt][nt] = accS[mt][nt] * decay;
#pragma unroll
            for (int k4 = 0; k4 < 4; ++k4) {
                bf16x8 Af[2], Bf[2];
#pragma unroll
                for (int mt = 0; mt < 2; ++mt) Af[mt] = cat4(tr_read(Vzs + (32 * k4 + 8 * g + q4) * VROW + (16 * mt + 4 * p4) * 2), tr_read(Vzs + (32 * k4 + 8 * g + 4 + q4) * VROW + (16 * mt + 4 * p4) * 2));
#pragma unroll
                for (int nt = 0; nt < 2; ++nt) Bf[nt] = cat4(tr_read(Ks + (32 * k4 + 8 * g + q4) * KROW + (32 * wave + 16 * nt + 4 * p4) * 2), tr_read(Ks + (32 * k4 + 8 * g + 4 + q4) * KROW + (32 * wave + 16 * nt + 4 * p4) * 2));
#pragma unroll
                for (int mt = 0; mt < 2; ++mt)
#pragma unroll
                    for (int nt = 0; nt < 2; ++nt) accS[mt][nt] = mfma16(Af[mt], Bf[nt], accS[mt][nt]);
            }
#pragma unroll
            for (int mt = 0; mt < 2; ++mt)
#pragma unroll
                for (int nt = 0; nt < 2; ++nt)
#pragma unroll
                    for (int r = 0; r < 4; ++r) *(LAS bf16*)(Sn + (16 * mt + 4 * g + r) * SROW + (32 * wave + 16 * nt + c16) * 2) = (bf16)(cvt_pk_bf16(accS[mt][nt][r], 0.f) & 0xffffu);
        }
        cur ^= 1;
    }
#undef SCAN_LOAD
    WG_BAR();
}

struct ConvRegs { u32x4 z0[2], z1[2], z2[2], cb[2]; };
__device__ __forceinline__ void conv_load(const bf16* CB, const bf16* Z, int idx, int nthr, int c8, ConvRegs& r) {
#pragma unroll
    for (int u = 0; u < 2; ++u) { const int t = (idx + u * nthr) >> 7, pos = t & (SEQ - 1);
        r.z0[u] = *(const u32x4*)(Z + (size_t)t * D + 8 * c8);
        r.z1[u] = (u32x4){0u, 0u, 0u, 0u}; r.z2[u] = (u32x4){0u, 0u, 0u, 0u};
        if (pos >= 1) r.z1[u] = *(const u32x4*)(Z + (size_t)(t - 1) * D + 8 * c8);
        if (pos >= 2) r.z2[u] = *(const u32x4*)(Z + (size_t)(t - 2) * D + 8 * c8);
        r.cb[u] = *(const u32x4*)(CB + (size_t)t * D + 8 * c8); }
}
__device__ __forceinline__ void conv_finish(bf16* Yb, const f32x4 (&cwv)[6], int idx, int nthr, int c8, const ConvRegs& r) {
#pragma unroll
    for (int u = 0; u < 2; ++u) { const int t = (idx + u * nthr) >> 7;
        float y[8];
        const unsigned zz0[4] = {r.z0[u].x, r.z0[u].y, r.z0[u].z, r.z0[u].w}, zz1[4] = {r.z1[u].x, r.z1[u].y, r.z1[u].z, r.z1[u].w}, zz2[4] = {r.z2[u].x, r.z2[u].y, r.z2[u].z, r.z2[u].w}, cc[4] = {r.cb[u].x, r.cb[u].y, r.cb[u].z, r.cb[u].w};
#pragma unroll
        for (int k = 0; k < 4; ++k) {
            const float wa0 = k < 2 ? cwv[0][2 * k] : cwv[1][2 * k - 4], wb0 = k < 2 ? cwv[0][2 * k + 1] : cwv[1][2 * k - 3];
            const float wa1 = k < 2 ? cwv[2][2 * k] : cwv[3][2 * k - 4], wb1 = k < 2 ? cwv[2][2 * k + 1] : cwv[3][2 * k - 3];
            const float wa2 = k < 2 ? cwv[4][2 * k] : cwv[5][2 * k - 4], wb2 = k < 2 ? cwv[4][2 * k + 1] : cwv[5][2 * k - 3];
            y[2 * k] = bf_lo(cc[k]) * (wa0 * bf_lo(zz2[k]) + wa1 * bf_lo(zz1[k]) + wa2 * bf_lo(zz0[k]));
            y[2 * k + 1] = bf_hi(cc[k]) * (wb0 * bf_hi(zz2[k]) + wb1 * bf_hi(zz1[k]) + wb2 * bf_hi(zz0[k]));
        }
        u32x4 w; w.x = cvt_pk_bf16(y[0], y[1]); w.y = cvt_pk_bf16(y[2], y[3]); w.z = cvt_pk_bf16(y[4], y[5]); w.w = cvt_pk_bf16(y[6], y[7]);
        *(u32x4*)(Yb + (size_t)t * D + 8 * c8) = w; }
}
__device__ __forceinline__ void swa_phase(LAS unsigned char* lds, const bf16* SQ, const bf16* SKV, bf16* Yc, const float* sinks, int vcu, int G, int tid, int lane, int wave,
                                          const bool fuse, const bf16* CB, const bf16* Z, const float* cw, bf16* Yb, int gtid, int nthr) {
    const int cc8 = gtid & 127; int cit = 0;
    f32x4 cwv[6];
#pragma unroll
    for (int j = 0; j < 3; ++j) { cwv[2 * j] = *(const f32x4*)(cw + j * D + 8 * cc8); cwv[2 * j + 1] = *(const f32x4*)(cw + j * D + 8 * cc8 + 4); }
    constexpr int ROWB = 144;
    LAS unsigned char* Ks = lds; LAS unsigned char* Vs = lds + 256 * ROWB;
    const int g = lane >> 4, c16 = lane & 15, q4 = (lane >> 2) & 3, p4 = lane & 3;
    for (int unit = vcu; unit < 512; unit += G) {
        const int b = unit >> 6, nb = (unit >> 1) & 31, kvh = unit & 1;
        const size_t tok_cur = (size_t)b * SEQ + 128 * nb, tok_prev = nb > 0 ? tok_cur - 128 : tok_cur;
        const bf16* qsrc = SQ + (tok_cur + 16 * wave + c16) * D + 64 * (8 * kvh) + 8 * g;
        bf16x8 qn0 = *(const bf16x8*)(qsrc), qn1 = *(const bf16x8*)(qsrc + 32);
        u32x4 kr[4], vr[4];
        { const int row = tid >> 1, half = tid & 1; const size_t tok = row < 128 ? tok_prev + row : tok_cur + (row - 128);
            const bf16* src = SKV + tok * 256 + 64 * kvh + 32 * half;
#pragma unroll
            for (int i = 0; i < 4; ++i) { kr[i] = *(const u32x4*)(src + 8 * i); vr[i] = *(const u32x4*)(src + 128 + 8 * i); }
            WG_BAR();
#pragma unroll
            for (int i = 0; i < 4; ++i) { *(LAS u32x4*)(Ks + row * ROWB + half * 64 + 16 * i) = kr[i]; *(LAS u32x4*)(Vs + row * ROWB + half * 64 + 16 * i) = vr[i]; }
        }
        WG_BAR();
        const int jt0 = 2 * (wave >> 1), iq = 16 * wave + c16;
        for (int hq = 0; hq < 8; ++hq) {
            const float sink = sinks[8 * kvh + hq];
            const bf16x8 q0 = qn0, q1 = qn1;
            int iqm = iq; asm volatile("" : "+v"(iqm));
            ConvRegs cr; const bool doconv = fuse && cit < 16;
            if (doconv) conv_load(CB, Z, gtid + cit * 2 * nthr, nthr, cc8, cr);
            if (hq < 7) { qn0 = *(const bf16x8*)(qsrc + 64 * (hq + 1)); qn1 = *(const bf16x8*)(qsrc + 64 * (hq + 1) + 32); }
            f32x4 st[10];
#pragma unroll
            for (int hf = 0; hf < 2; ++hf) {
                bf16x8 fk[10];
#pragma unroll
                for (int t = 0; t < 5; ++t)
#pragma unroll
                    for (int ks = 0; ks < 2; ++ks) fk[2 * t + ks] = *(const LAS bf16x8*)(Ks + (16 * (jt0 + 5 * hf + t) + c16) * ROWB + (32 * ks + 8 * g) * 2);
                asm volatile("" ::: "memory");
#pragma unroll
                for (int t = 0; t < 5; ++t) { st[5 * hf + t] = mfma16(fk[2 * t], q0, (f32x4){0.f, 0.f, 0.f, 0.f}); st[5 * hf + t] = mfma16(fk[2 * t + 1], q1, st[5 * hf + t]); }
            }
            float mx = sink;
#pragma unroll
            for (int t = 0; t < 10; ++t)
#pragma unroll
                for (int r = 0; r < 4; ++r) { const int j = 16 * (jt0 + t) + 4 * g + r, d = iqm + 128 - j; const bool valid = (d >= 0) && (d < 128) && (nb > 0 || j >= 128);
                    st[t][r] = valid ? st[t][r] : -INFINITY; mx = fmaxf(mx, st[t][r]); }
            mx = fmaxf(mx, __shfl_xor(mx, 16)); mx = fmaxf(mx, __shfl_xor(mx, 32));
            float sum = 0.f;
#pragma unroll
            for (int t = 0; t < 10; ++t)
#pragma unroll
                for (int r = 0; r < 4; ++r) { st[t][r] = __builtin_amdgcn_exp2f((st[t][r] - mx) * LOG2E); sum += st[t][r]; }
            sum += __shfl_xor(sum, 16); sum += __shfl_xor(sum, 32);
            const float inv = 1.0f / (sum + __builtin_amdgcn_exp2f((sink - mx) * LOG2E));
            f32x4 o[4];
#pragma unroll
            for (int dt = 0; dt < 4; ++dt) o[dt] = (f32x4){0.f, 0.f, 0.f, 0.f};
#pragma unroll
            for (int kbi = 0; kbi < 5; ++kbi) {
                u32x4 pw; pw.x = cvt_pk_bf16(st[2 * kbi][0], st[2 * kbi][1]); pw.y = cvt_pk_bf16(st[2 * kbi][2], st[2 * kbi][3]);
                pw.z = cvt_pk_bf16(st[2 * kbi + 1][0], st[2 * kbi + 1][1]); pw.w = cvt_pk_bf16(st[2 * kbi + 1][2], st[2 * kbi + 1][3]);
                const bf16x8 pb = __builtin_bit_cast(bf16x8, pw);
                s16x4 lo[4], hi[4];
#pragma unroll
                for (int dt = 0; dt < 4; ++dt) { lo[dt] = tr_read(Vs + (16 * (jt0 + 2 * kbi) + 4 * g + q4) * ROWB + (16 * dt + 4 * p4) * 2); hi[dt] = tr_read(Vs + (16 * (jt0 + 2 * kbi + 1) + 4 * g + q4) * ROWB + (16 * dt + 4 * p4) * 2); }
                asm volatile("" ::: "memory");
#pragma unroll
                for (int dt = 0; dt < 4; ++dt) o[dt] = mfma16(cat4(lo[dt], hi[dt]), pb, o[dt]);
            }
#pragma unroll
            for (int dt = 0; dt < 4; ++dt) { u32x2 w; w.x = cvt_pk_bf16(o[dt][0] * inv, o[dt][1] * inv); w.y = cvt_pk_bf16(o[dt][2] * inv, o[dt][3] * inv);
                *(u32x2*)(Yc + (tok_cur + iq) * D + 64 * (8 * kvh + hq) + 16 * dt + 4 * g) = w; }
            if (doconv) conv_finish(Yb, cwv, gtid + cit * 2 * nthr, nthr, cc8, cr);
            ++cit;
        }
    }
    WG_BAR();
}
__device__ __forceinline__ void ya_pass(const bf16* R, const bf16* RG, const float* ssq, bf16* Ya, int gtid, int nthr) {
    for (int idx = gtid; idx < M * 128; idx += 2 * nthr) {
        u32x4 r[2], gq[2]; f32x4 s0[2], s1[2];
#pragma unroll
        for (int u = 0; u < 2; ++u) { const int i = idx + u * nthr, t = i >> 7, c8 = i & 127, h = c8 >> 5;
            const f32x4* sp = (const f32x4*)(ssq + ((size_t)t * 4 + h) * 8); s0[u] = sp[0]; s1[u] = sp[1];
            r[u] = *(const u32x4*)(R + (size_t)t * D + 8 * c8); gq[u] = *(const u32x4*)(RG + (size_t)t * D + 8 * c8); }
#pragma unroll
        for (int u = 0; u < 2; ++u) { const int i = idx + u * nthr, t = i >> 7, c8 = i & 127;
            const float tot = ((s0[u][0] + s0[u][1]) + (s0[u][2] + s0[u][3])) + ((s1[u][0] + s1[u][1]) + (s1[u][2] + s1[u][3]));
            const float rstd = 1.0f / sqrtf(tot * (1.0f / 256.0f) + EPS);
            u32x4 w;
            w.x = cvt_pk_bf16(bf_lo(gq[u].x) * (bf_lo(r[u].x) * rstd), bf_hi(gq[u].x) * (bf_hi(r[u].x) * rstd)); w.y = cvt_pk_bf16(bf_lo(gq[u].y) * (bf_lo(r[u].y) * rstd), bf_hi(gq[u].y) * (bf_hi(r[u].y) * rstd));
            w.z = cvt_pk_bf16(bf_lo(gq[u].z) * (bf_lo(r[u].z) * rstd), bf_hi(gq[u].z) * (bf_hi(r[u].z) * rstd)); w.w = cvt_pk_bf16(bf_lo(gq[u].w) * (bf_lo(r[u].w) * rstd), bf_hi(gq[u].w) * (bf_hi(r[u].w) * rstd));
            *(u32x4*)(Ya + (size_t)t * D + 8 * c8) = w; }
    }
}
__device__ __forceinline__ void conv_pass(const bf16* CB, const bf16* Z, const float* cw, bf16* Yb, int gtid, int nthr) {
    const int c8 = gtid & 127;
    const f32x4 w0a = *(const f32x4*)(cw + 8 * c8), w0b = *(const f32x4*)(cw + 8 * c8 + 4), w1a = *(const f32x4*)(cw + D + 8 * c8), w1b = *(const f32x4*)(cw + D + 8 * c8 + 4),
                w2a = *(const f32x4*)(cw + 2 * D + 8 * c8), w2b = *(const f32x4*)(cw + 2 * D + 8 * c8 + 4);
    for (int idx = gtid; idx < M * 128; idx += 2 * nthr) {
        u32x4 z0[2], z1[2], z2[2], cbv[2];
#pragma unroll
        for (int u = 0; u < 2; ++u) { const int t = (idx + u * nthr) >> 7, pos = t & (SEQ - 1);
            z0[u] = *(const u32x4*)(Z + (size_t)t * D + 8 * c8);
            z1[u] = (u32x4){0u, 0u, 0u, 0u}; z2[u] = (u32x4){0u, 0u, 0u, 0u};
            if (pos >= 1) z1[u] = *(const u32x4*)(Z + (size_t)(t - 1) * D + 8 * c8);
            if (pos >= 2) z2[u] = *(const u32x4*)(Z + (size_t)(t - 2) * D + 8 * c8);
            cbv[u] = *(const u32x4*)(CB + (size_t)t * D + 8 * c8); }
#pragma unroll
        for (int u = 0; u < 2; ++u) { const int t = (idx + u * nthr) >> 7;
            float y[8];
            const unsigned zz0[4] = {z0[u].x, z0[u].y, z0[u].z, z0[u].w}, zz1[4] = {z1[u].x, z1[u].y, z1[u].z, z1[u].w}, zz2[4] = {z2[u].x, z2[u].y, z2[u].z, z2[u].w}, cc[4] = {cbv[u].x, cbv[u].y, cbv[u].z, cbv[u].w};
#pragma unroll
            for (int k = 0; k < 4; ++k) {
                const float wa0 = k < 2 ? w0a[2 * k] : w0b[2 * k - 4], wb0 = k < 2 ? w0a[2 * k + 1] : w0b[2 * k - 3];
                const float wa1 = k < 2 ? w1a[2 * k] : w1b[2 * k - 4], wb1 = k < 2 ? w1a[2 * k + 1] : w1b[2 * k - 3];
                const float wa2 = k < 2 ? w2a[2 * k] : w2b[2 * k - 4], wb2 = k < 2 ? w2a[2 * k + 1] : w2b[2 * k - 3];
                y[2 * k] = bf_lo(cc[k]) * (wa0 * bf_lo(zz2[k]) + wa1 * bf_lo(zz1[k]) + wa2 * bf_lo(zz0[k]));
                y[2 * k + 1] = bf_hi(cc[k]) * (wb0 * bf_hi(zz2[k]) + wb1 * bf_hi(zz1[k]) + wb2 * bf_hi(zz0[k]));
            }
            u32x4 w; w.x = cvt_pk_bf16(y[0], y[1]); w.y = cvt_pk_bf16(y[2], y[3]); w.z = cvt_pk_bf16(y[4], y[5]); w.w = cvt_pk_bf16(y[6], y[7]);
            *(u32x4*)(Yb + (size_t)t * D + 8 * c8) = w; }
    }
}

#define RLX_AGENT __ATOMIC_RELAXED, __HIP_MEMORY_SCOPE_AGENT
#define XB_TMO      128
#define XB_XCNT(j)  (256  + 64 * (j))
#define XB_XSUB(j)  (1280 + 64 * (j))
#define XB_XGEN(j)  (2304 + 64 * (j))
#define XB_TOP      3328
#define XB_TOPGEN   3392
#define XCD_BAR_WORDS 3456
#define XB_SPIN_CAP (1u << 18)

__device__ __forceinline__ unsigned xb_ld(unsigned* p)              { return __hip_atomic_load(p, __ATOMIC_RELAXED, __HIP_MEMORY_SCOPE_AGENT); }
__device__ __forceinline__ unsigned xb_add(unsigned* p, unsigned v) { return __hip_atomic_fetch_add(p, v, __ATOMIC_RELAXED, __HIP_MEMORY_SCOPE_AGENT); }
__device__ __forceinline__ unsigned xb_xcc_id() { return (unsigned)__builtin_amdgcn_s_getreg((3 << 11) | 20) & 0xFu; }
#define XB_SPIN(cond, bar) do { unsigned _sp = 0; while (cond) { __builtin_amdgcn_s_sleep(1); \
    if ((++_sp & 255u) == 0u) { if (xb_ld(&(bar)[XB_TMO])) break; if (_sp > XB_SPIN_CAP) { atomicAdd(&(bar)[XB_TMO], 1u); break; } } } } while (0)

struct XcdBarrier {
    unsigned* bar; unsigned x;
    volatile LAS unsigned* st;
};

__device__ __forceinline__ XcdBarrier xcd_barrier_post(unsigned* bar, volatile LAS unsigned* st) {
    XcdBarrier b; b.bar = bar; b.x = xb_xcc_id(); b.st = st;
    if (threadIdx.x == 0) (void)xb_add(&bar[XB_XCNT(b.x)], 1u);
    return b;
}
__device__ __forceinline__ void xcd_barrier_complete(unsigned* bar, unsigned x, unsigned& nloc, unsigned& nx) {
    const unsigned G = gridDim.x * gridDim.y * gridDim.z;
    unsigned sum, cnt, mine, sp = 0u;
    for (;;) {
        sum = 0u; cnt = 0u; mine = 0u;
#pragma unroll
        for (unsigned j = 0; j < 16; ++j) { const unsigned c = xb_ld(&bar[XB_XCNT(j)]); sum += c; cnt += (c > 0u) ? 1u : 0u; mine = (j == x) ? c : mine; }
        if (sum == G) break;
        __builtin_amdgcn_s_sleep(1);
        if ((++sp & 255u) == 0u) { if (xb_ld(&bar[XB_TMO])) break; if (sp > XB_SPIN_CAP) { atomicAdd(&bar[XB_TMO], 1u); break; } }
    }
    nloc = mine > 0u ? mine : 1u; nx = cnt > 0u ? cnt : 1u;
}

__device__ __forceinline__ void xcd_barrier(const XcdBarrier& b) {
    asm volatile("s_waitcnt vmcnt(0)" ::: "memory");
    __syncthreads();
    if (threadIdx.x == 0) {
        unsigned* bar = b.bar;
        __builtin_amdgcn_s_waitcnt(0);
        unsigned nloc = b.st[0], nx = b.st[1];
        if (nloc == 0u) { xcd_barrier_complete(bar, b.x, nloc, nx); b.st[0] = nloc; b.st[1] = nx; }
        const unsigned old = xb_add(&bar[XB_XSUB(b.x)], 1u);
        const unsigned gen = old / nloc;
        if (old + 1u == (gen + 1u) * nloc) {
            __builtin_amdgcn_fence(__ATOMIC_RELEASE, "agent");
            asm volatile("s_waitcnt vmcnt(0)" ::: "memory");
            const unsigned og = xb_add(&bar[XB_TOP], 1u);
            const unsigned tg = og / nx;
            if (og + 1u == (tg + 1u) * nx) xb_add(&bar[XB_TOPGEN], 1u);
            else XB_SPIN(xb_ld(&bar[XB_TOPGEN]) == tg, bar);
            __builtin_amdgcn_fence(__ATOMIC_ACQUIRE, "agent");
            xb_add(&bar[XB_XGEN(b.x)], 1u);
            asm volatile("s_waitcnt vmcnt(0)" ::: "memory");
        } else {
            XB_SPIN(xb_ld(&bar[XB_XGEN(b.x)]) == gen, bar);
            __builtin_amdgcn_fence(__ATOMIC_ACQUIRE, "agent");
            asm volatile("s_waitcnt vmcnt(0)" ::: "memory");
        }
    }
    __syncthreads();
}

struct Args { const float* in[21]; float* out; unsigned char* ws; int ph_lo, ph_hi, dump_mib, pad; };

__global__ void __launch_bounds__(512) hybrid_fwd(Args a) {
    extern __shared__ __attribute__((aligned(16))) unsigned char lds_raw[];
    LAS unsigned char* lds = (LAS unsigned char*)lds_raw;
#if MK_ONE_LAUNCH
    if (threadIdx.x < 2) ((volatile LAS unsigned*)(lds + MISC_OFF))[threadIdx.x] = 0u;
    __syncthreads();
    const XcdBarrier xbar = xcd_barrier_post((unsigned*)a.ws + CW_BAR, (volatile LAS unsigned*)(lds + MISC_OFF));
#endif
    for (int ph = a.ph_lo; ph < a.ph_hi; ++ph) {
        int tid = threadIdx.x; asm volatile("" : "+v"(tid));
        int G = gridDim.x, bx = blockIdx.x; asm volatile("" : "+s"(G), "+s"(bx));
        const int vcu = (G % 8 == 0) ? (bx % 8) * (G / 8) + bx / 8 : bx;
        const int lane = tid & 63, wave = __builtin_amdgcn_readfirstlane(tid >> 6);
        const int gw = vcu * 8 + wave, ngw = G * 8, gtid = vcu * 512 + tid, nthr = G * 512;
        const __attribute__((address_space(4))) Args* ap = (const __attribute__((address_space(4))) Args*)__builtin_amdgcn_kernarg_segment_ptr(); asm volatile("" : "+s"(ap));
        unsigned char* ws = ap->ws;
        float* H = ap->out;
        const float* mod = (const float*)(ws + WS_MOD);
        LAS float* scr = (LAS float*)(lds + wave * 8448);
        bf16* U = (bf16*)(ws + WS_U);
        unsigned char* big = ws + WS_BIG;
        bf16* Yb = (bf16*)(ws + WS_Y); bf16* Yc = (bf16*)(ws + WS_Y + PLANE); bf16* Ya = (bf16*)(ws + WS_Y + 2 * PLANE);
#if MK_ONE_LAUNCH
        if (ph > a.ph_lo) { if (ph == a.ph_lo + 1) cg::this_grid().sync(); else xcd_barrier(xbar); }
#endif
        if (ph == 100) {
            const bf16* src = (const bf16*)(ap->ws + (size_t)ap->dump_mib * MiB); float* o = ap->out;
            for (int i = vcu * 512 + tid; i < M * D; i += G * 512) o[i] = __uint_as_float(((unsigned)src[i]) << 16);
            continue; }
        if (ph == 0) { p0_phase(lds, ap->in[1], ap->in[2], ap->in[3], ws, vcu, G, tid, lane, wave); continue; }
        if (ph == NPHASE - 1) { final_norm_rows(H, ap->in[20], gw, ngw, lane); continue; }
#ifndef MK_DUP_NOP
#define MK_DUP_NOP 0
#endif
#ifdef MK_DUP_K
        const int l = (ph - 1) / 15, slot_ = (ph - 1) % 15, k = slot_ <= MK_DUP_K ? slot_ : slot_ - 1;
        const bool dupnop = (slot_ == MK_DUP_K + 1) && MK_DUP_NOP;
#else
        const int l = (ph - 1) / 14, k = (ph - 1) % 14;
        const bool dupnop = false;
#endif
        const float* modl = mod + (size_t)l * 8 * MODW;
        if (k == 1 || k == 12) {
            const pg8::Gemm g{U, (const bf16*)(ws + W_W13), M, 2 * DFF, D, D, 30, 0}; const pg8::EpiUp eu{(bf16*)big, dupnop};
            pg8::StaticOrder S; S.init(M, 2 * DFF, G, bx); pg8::gemm_phase<pg8::EpiUp>(lds, g, S, eu, tid);
        } else if (k == 2 || k == 13 || k == 10) {
            const bool wo = (k == 10); const int KK = wo ? D : DFF;
            const pg8::Gemm g{wo ? (const bf16*)U : (const bf16*)big, (const bf16*)(ws + (wo ? W_OUT : W_W2)), M, D, KK, KK, 30, 0};
            const pg8::EpiRes er{(l == 0 && k == 2) ? ap->in[0] : (const float*)H, H, modl + (k == 2 ? 2 : (wo ? 5 : 8)) * D, wo ? 1.0f : 0.5f};
            pg8::StaticOrder S; S.init(M, D, G, bx); pg8::gemm_phase<pg8::EpiRes>(lds, g, S, er, tid);
        } else if (k == 4 || k == 6 || k == 8) {
            const int grp = k == 4 ? 0 : (k == 6 ? 1 : 2), roff = grp == 0 ? 0 : (grp == 1 ? 4096 : 8448), NN = grp == 0 ? 4096 : (grp == 1 ? 4352 : 3072);
            if (k == 6) { if (G == 256) { if (bx >= 128) ya_pass(Ya, (const bf16*)(big + 208 * MiB), (const float*)(ws + WS_SSQ), Ya, (bx - 128) * 512 + tid, 128 * 512); }
                          else ya_pass(Ya, (const bf16*)(big + 208 * MiB), (const float*)(ws + WS_SSQ), Ya, gtid, nthr); }
            const pg8::Gemm g{U, (const bf16*)(ws + W_IN) + (size_t)roff * D, M, NN, D, D, 30, 0}; const pg8::EpiProj ep{big, grp, (const float*)(ws + WS_ROT)};
            pg8::StaticOrder S; S.init(M, NN, G, bx); pg8::gemm_phase<pg8::EpiProj>(lds, g, S, ep, tid);
        } else if (k == 9) {
            const pg8::Gemm g{Yb, (const bf16*)(ws + W_PCAT), M, D, 3 * D, D, 4, PLANE}; const pg8::EpiMerge em{(const bf16*)big, U};
            pg8::StaticOrder S; S.init(M, D, G, bx); pg8::gemm_phase<pg8::EpiMerge>(lds, g, S, em, tid);
        } else if (k == 0) {
            norm_rows(l == 0 ? ap->in[0] : (const float*)H, ap->in[4] + (size_t)l * D, modl + 0 * D, modl + 1 * D, U, gw, ngw, lane);
            convert_ffn(ap->in[5] + (size_t)l * D * DFF, ap->in[6] + (size_t)l * D * DFF, ap->in[7] + (size_t)l * D * DFF, ws, scr, gw, ngw, lane);
        } else if (k == 3) {
            norm_rows(H, ap->in[8] + (size_t)l * D, modl + 3 * D, modl + 4 * D, U, gw, ngw, lane);
            convert_mixer(ap->in[9] + (size_t)l * D * INC, ap->in[12] + (size_t)l * D * D, ap->in[13] + (size_t)l * D * D, ap->in[14] + (size_t)l * D * D, ap->in[15] + (size_t)l * D * D, ws, scr, gw, ngw, lane);
        } else if (k == 11) {
            norm_rows(H, ap->in[16] + (size_t)l * D, modl + 6 * D, modl + 7 * D, U, gw, ngw, lane);
            convert_ffn(ap->in[17] + (size_t)l * D * DFF, ap->in[18] + (size_t)l * D * DFF, ap->in[19] + (size_t)l * D * DFF, ws, scr, gw, ngw, lane);
        } else if (k == 5) {
#ifdef MK_SCAN_PMODE
            if (dupnop) scan_phase(lds, (const bf16*)big, (const bf16*)(big + PLANE), (const bf16*)(big + 2 * PLANE), Yc, (float*)(ws + WS_SSQ), vcu, tid, lane, wave, MK_SCAN_PMODE);
            else
#endif
            scan_phase(lds, (const bf16*)big, (const bf16*)(big + PLANE), (const bf16*)(big + 2 * PLANE), Ya, (float*)(ws + WS_SSQ), vcu, tid, lane, wave);
        } else if (k == 7) {
            const bool fuse = (G == 256);
            swa_phase(lds, (const bf16*)(big + 2 * PLANE), (const bf16*)(big + 3 * PLANE), Yc, ap->in[11] + (size_t)l * 16, vcu, G, tid, lane, wave,
                      fuse, (const bf16*)big, (const bf16*)(big + PLANE), ap->in[10] + (size_t)l * 3 * D, Yb, gtid, nthr);
            if (!fuse) conv_pass((const bf16*)big, (const bf16*)(big + PLANE), ap->in[10] + (size_t)l * 3 * D, Yb, gtid, nthr);
        }
    }
}

extern "C" void kernel_launch(void* const* d_in, const int* in_sizes, int n_in, void* d_out, int out_size, void* d_ws, size_t ws_size, hipStream_t stream) {
    static int grid = 0;
    if (grid == 0) {
        if (n_in != 21 || in_sizes[0] != M * D || out_size != M * D || ws_size < WS_END) { fprintf(stderr, "kernel_launch: unexpected shapes / workspace (n_in %d, in0 %d, out %d, ws %zu < %zu)\n", n_in, n_in > 0 ? in_sizes[0] : -1, out_size, ws_size, (size_t)WS_END); grid = -1; return; }
        if (hipFuncSetAttribute((const void*)hybrid_fwd, hipFuncAttributeMaxDynamicSharedMemorySize, LDS_BYTES) != hipSuccess) { fprintf(stderr, "kernel_launch: hipFuncSetAttribute failed\n"); grid = -1; return; }
        int dev = 0, cus = 0, per_cu = 0;
        (void)hipGetDevice(&dev); (void)hipDeviceGetAttribute(&cus, hipDeviceAttributeMultiprocessorCount, dev);
        (void)hipOccupancyMaxActiveBlocksPerMultiprocessor(&per_cu, (const void*)hybrid_fwd, 512, LDS_BYTES);
        (void)hipGetLastError();
        if (per_cu < 1) { fprintf(stderr, "kernel_launch: occupancy query says %d blocks per CU\n", per_cu); per_cu = 1; }
        grid = cus * 1;
        if (grid != 256) fprintf(stderr, "kernel_launch: note: %d CUs\n", grid);
    }
    if (grid < 0) return;
    Args a{};
    for (int i = 0; i < 21; ++i) a.in[i] = (const float*)d_in[i];
    a.out = (float*)d_out; a.ws = (unsigned char*)d_ws;
#if MK_ONE_LAUNCH
    if (hipMemsetAsync(d_ws, 0, CTL_ZERO_BYTES, stream) != hipSuccess) { fprintf(stderr, "kernel_launch: hipMemsetAsync failed\n"); return; }
    a.ph_lo = 0; a.ph_hi = NPHASE;
    void* args[] = {&a};
    hipError_t e = hipLaunchCooperativeKernel((const void*)hybrid_fwd, dim3(grid), dim3(512), args, LDS_BYTES, stream);
    if (e != hipSuccess) fprintf(stderr, "kernel_launch: cooperative launch failed: %s (grid %d)\n", hipGetErrorString(e), grid);
#else
#ifndef MK_CUT
#define MK_CUT NPHASE
#endif
    for (int ph = 0; ph < MK_CUT; ++ph) { a.ph_lo = ph; a.ph_hi = ph + 1; hipLaunchKernelGGL(hybrid_fwd, dim3(grid), dim3(512), LDS_BYTES, stream, a); }
#ifdef MK_DUMP
    a.ph_lo = 100; a.ph_hi = 101; a.dump_mib = MK_DUMP; hipLaunchKernelGGL(hybrid_fwd, dim3(grid), dim3(512), LDS_BYTES, stream, a);
#endif
#endif
}
```

```cpp
#include <hip/hip_runtime.h>
#include <hip/hip_cooperative_groups.h>
#include <cstdio>
#include <cstdint>
namespace cg = cooperative_groups;

#ifndef MK_ONE_LAUNCH
#define MK_ONE_LAUNCH 1
#endif

#define LAS __attribute__((address_space(3)))
typedef unsigned short bf16;
typedef short bf16x8 __attribute__((ext_vector_type(8)));
typedef short s16x4 __attribute__((ext_vector_type(4)));
typedef float f32x4 __attribute__((ext_vector_type(4)));
typedef float f32x2 __attribute__((ext_vector_type(2)));
typedef unsigned u32x4 __attribute__((ext_vector_type(4)));
typedef unsigned u32x2 __attribute__((ext_vector_type(2)));

constexpr int D = 1024, BATCH = 8, SEQ = 4096, M = BATCH * SEQ, DFF = 2816, INC = 11520, MODW = 9 * D;
constexpr float EPS = 1e-6f;
constexpr float LOG2E = 1.4426950408889634f;
constexpr size_t MiB = 1u << 20;
constexpr size_t WS_MOD = 1 * MiB;
constexpr size_t WS_ROT = 2 * MiB;
constexpr size_t WS_SSQ = 6 * MiB;
constexpr size_t WS_W = 10 * MiB;
constexpr size_t W_W13 = WS_W, W_W2 = WS_W + 11 * MiB;
constexpr size_t W_IN = WS_W, W_PCAT = WS_W + 23 * MiB, W_OUT = WS_W + 29 * MiB;
constexpr size_t WS_U = 42 * MiB;
constexpr size_t WS_BIG = 106 * MiB;
constexpr size_t PLANE = 64 * MiB;
constexpr size_t WS_Y = WS_BIG + 208 * MiB;
constexpr size_t WS_END = WS_Y + 3 * PLANE;
constexpr int LDS_BYTES = 147456;
#ifdef MK_DUP_K
constexpr int NPHASE = 32;
#else
constexpr int NPHASE = 30;
#endif
constexpr int CW_BAR = 4096;
constexpr size_t CTL_ZERO_BYTES = 65536;
constexpr int MISC_OFF = 131072 + 64;

typedef __bf16 bf16x2_t __attribute__((ext_vector_type(2)));
__device__ __forceinline__ unsigned cvt_pk_bf16(float lo, float hi) { const f32x2 v = {lo, hi}; const bf16x2_t b = __builtin_convertvector(v, bf16x2_t); return __builtin_bit_cast(unsigned, b); }
__device__ __forceinline__ float bf_lo(unsigned w) { return __uint_as_float(w << 16); }
__device__ __forceinline__ float bf_hi(unsigned w) { return __uint_as_float(w & 0xffff0000u); }
__device__ __forceinline__ float silu_f(float x) { return x * __builtin_amdgcn_rcpf(1.0f + __builtin_amdgcn_exp2f(-LOG2E * x)); }
__device__ __forceinline__ float sigmoid_f(float x) { return __builtin_amdgcn_rcpf(1.0f + __builtin_amdgcn_exp2f(-LOG2E * x)); }
__device__ __forceinline__ f32x4 mfma16(bf16x8 a, bf16x8 b, f32x4 c) { return __builtin_amdgcn_mfma_f32_16x16x32_bf16(a, b, c, 0, 0, 0); }
typedef short v4i16_t __attribute__((ext_vector_type(4)));
__device__ __forceinline__ s16x4 tr_read(LAS const unsigned char* p) { return __builtin_bit_cast(s16x4, __builtin_amdgcn_ds_read_tr16_b64_v4i16((LAS v4i16_t*)p)); }
__device__ __forceinline__ bf16x8 cat4(s16x4 lo, s16x4 hi) { return (bf16x8){lo[0], lo[1], lo[2], lo[3], hi[0], hi[1], hi[2], hi[3]}; }
#define LDS_WAIT() asm volatile("s_waitcnt lgkmcnt(0)" ::: "memory")
#define WG_BAR() do { asm volatile("s_waitcnt lgkmcnt(0)" ::: "memory"); __builtin_amdgcn_s_barrier(); asm volatile("" ::: "memory"); } while (0)
__device__ __forceinline__ float wave_sum(float v) {
#pragma unroll
    for (int o = 1; o < 64; o <<= 1) v += __shfl_xor(v, o);
    return v;
}

namespace pg8 {
constexpr int BM = 256, BK = 64, HALF = 128, HTB = HALF * BK * 2, STAGE_BYTES = 8 * HTB, NXCD = 8, WGM = 8;
__host__ __device__ __forceinline__ int lds_byte(int r, int c) { const int st = (r >> 4) * 2 + (c >> 5), rr = r & 15, cc = c & 31, ob = rr * 64 + cc * 2; return st * 1024 + (ob ^ (((ob >> 9) & 1) << 5)); }
__host__ __device__ __forceinline__ void stage_rc(int b, int& R, int& C) { const int st = b / 1024, sb = b % 1024, swz = sb ^ (((sb >> 9) & 1) << 5); R = (st >> 1) * 16 + swz / 64; C = (st & 1) * 32 + (swz % 64) / 2; }
__host__ __device__ __forceinline__ int perm32(int rho) { const int n = rho >> 4, i = rho & 15; return 8 * (i >> 2) + 4 * n + (i & 3); }

struct Unit { int pm, pn; };
struct Gemm { const bf16* A; const bf16* Bt; int M, N, K, lda, segShift; size_t segStride; };

struct StaticOrder {
    int nM, nN, nwg, G, c;
    __device__ void init(int M_, int N_, int G_, int c_) { nM = M_ / BM; nN = N_ / BM; nwg = nM * nN; G = G_; c = c_; }
    __device__ bool next(int i, Unit& u) const {
        const long L = (long)i * G + c; if (L >= nwg) return false;
        int wgid = (int)L; { const int q = nwg / NXCD, r = nwg % NXCD, xcd = wgid % NXCD, off = wgid / NXCD; wgid = (xcd < r ? xcd * (q + 1) : r * (q + 1) + (xcd - r) * q) + off; }
        const int nig = WGM * nN, gid = wgid / nig, fm = gid * WGM, gsz = (nM - fm) < WGM ? (nM - fm) : WGM;
        u.pm = fm + ((wgid % nig) % gsz); u.pn = (wgid % nig) / gsz; return true;
    }
};

typedef f32x4 Acc[2][2][4][2];

struct EpiUp {
    static constexpr bool PERM = true, HAS_MID = false;
    bf16* O; bool nop;
    __device__ __forceinline__ void mid(Acc&, const Unit&, int, int, int, int, int) const {}
    __device__ __forceinline__ void operator()(const Acc& acc, const Unit& u, int wr, int wc, int fr, int fq) const {
        if (nop) return;
        const int row0 = u.pm * BM + wr * 64 + fr, col0 = u.pn * 128 + wc * 32 + 8 * fq;
#pragma unroll
        for (int ai = 0; ai < 2; ++ai)
#pragma unroll
            for (int m = 0; m < 4; ++m) {
                bf16* rowp = O + (size_t)(row0 + ai * HALF + m * 16) * DFF + col0;
                const f32x4 a0 = acc[ai][0][m][0], a1 = acc[ai][0][m][1], b0 = acc[ai][1][m][0], b1 = acc[ai][1][m][1];
                u32x4 w;
                w.x = cvt_pk_bf16(silu_f(a0[0]) * b0[0], silu_f(a0[1]) * b0[1]); w.y = cvt_pk_bf16(silu_f(a0[2]) * b0[2], silu_f(a0[3]) * b0[3]);
                w.z = cvt_pk_bf16(silu_f(a1[0]) * b1[0], silu_f(a1[1]) * b1[1]); w.w = cvt_pk_bf16(silu_f(a1[2]) * b1[2], silu_f(a1[3]) * b1[3]);
                *(u32x4*)rowp = w;
            }
    }
};
struct EpiRes {
    static constexpr bool PERM = false, HAS_MID = false;
    const void* Hin; void* Hout; const float* gate; float coef; int in_bf16, out_bf16;
    __device__ __forceinline__ void mid(Acc&, const Unit&, int, int, int, int, int) const {}
    __device__ __forceinline__ void operator()(const Acc& acc, const Unit& u, int wr, int wc, int fr, int fq) const {
        const int row0 = u.pm * BM + wr * 64 + fr, col0 = u.pn * BM + wc * 32 + 4 * fq, b = u.pm >> 4;
        f32x4 gv[2][2];
#pragma unroll
        for (int bj = 0; bj < 2; ++bj)
#pragma unroll
            for (int n = 0; n < 2; ++n) gv[bj][n] = *(const f32x4*)(gate + (size_t)b * MODW + col0 + bj * HALF + n * 16) * coef;
#pragma unroll
        for (int ah = 0; ah < 4; ++ah) { const int ai = ah >> 1, m0 = (ah & 1) * 2;
            f32x4 h[2][2][2];
            if (in_bf16) {
                u32x2 hb[2][2][2];
#pragma unroll
                for (int mm = 0; mm < 2; ++mm) { const size_t off = (size_t)(row0 + ai * HALF + (m0 + mm) * 16) * D + col0;
#pragma unroll
                    for (int bj = 0; bj < 2; ++bj)
#pragma unroll
                        for (int n = 0; n < 2; ++n) hb[mm][bj][n] = *(const u32x2*)((const bf16*)Hin + off + bj * HALF + n * 16); }
                asm volatile("" ::: "memory");
#pragma unroll
                for (int mm = 0; mm < 2; ++mm)
#pragma unroll
                    for (int bj = 0; bj < 2; ++bj)
#pragma unroll
                        for (int n = 0; n < 2; ++n) h[mm][bj][n] = (f32x4){bf_lo(hb[mm][bj][n].x), bf_hi(hb[mm][bj][n].x), bf_lo(hb[mm][bj][n].y), bf_hi(hb[mm][bj][n].y)};
            } else {
#pragma unroll
                for (int mm = 0; mm < 2; ++mm) { const size_t off = (size_t)(row0 + ai * HALF + (m0 + mm) * 16) * D + col0;
#pragma unroll
                    for (int bj = 0; bj < 2; ++bj)
#pragma unroll
                        for (int n = 0; n < 2; ++n) h[mm][bj][n] = *(const f32x4*)((const float*)Hin + off + bj * HALF + n * 16); }
                asm volatile("" ::: "memory");
            }
#pragma unroll
            for (int mm = 0; mm < 2; ++mm) { const size_t off = (size_t)(row0 + ai * HALF + (m0 + mm) * 16) * D + col0;
#pragma unroll
                for (int bj = 0; bj < 2; ++bj)
#pragma unroll
                    for (int n = 0; n < 2; ++n) { const f32x4 o = h[mm][bj][n] + gv[bj][n] * acc[ai][bj][m0 + mm][n];
                        if (out_bf16) { u32x2 w; w.x = cvt_pk_bf16(o[0], o[1]); w.y = cvt_pk_bf16(o[2], o[3]); *(u32x2*)((bf16*)Hout + off + bj * HALF + n * 16) = w; }
                        else *(f32x4*)((float*)Hout + off + bj * HALF + n * 16) = o; } }
            asm volatile("" ::: "memory");
        }
    }
};
struct EpiProj {
    static constexpr bool PERM = true, HAS_MID = false;
    unsigned char* big; int grp; const float* rot;
    __device__ __forceinline__ void mid(Acc&, const Unit&, int, int, int, int, int) const {}
    __device__ __forceinline__ void operator()(const Acc& acc, const Unit& u, int wr, int wc, int fr, int fq) const {
        int mode, plane, colt, ldc = D; float sc = 1.f; const int pn = u.pn;
        if (grp == 0) { plane = pn >> 2; colt = (pn & 3) * 256; mode = plane < 2 ? 1 : (plane == 2 ? 0 : 2); sc = plane == 1 ? 0.0625f : 1.f; }
        else if (grp == 1) {
            if (pn < 4) { plane = 0; colt = 256 * pn; mode = 0; }
            else if (pn < 12) { plane = 1; colt = 128 * (pn - 4); mode = 4; }
            else if (pn < 16) { plane = 2; colt = 256 * (pn - 12); mode = 0; sc = 0.125f; }
            else { plane = 3; colt = 0; mode = 0; ldc = 256; }
        } else { plane = pn >> 2; colt = (pn & 3) * 256; mode = 3; }
        bf16* O = (grp == 0 && plane == 3) ? (bf16*)(big + 208 * MiB) : (bf16*)(big + (size_t)plane * PLANE);
        const int row0 = u.pm * BM + wr * 64 + fr, cl = wc * 32 + 8 * fq;
        if (mode == 4) {
#pragma unroll
            for (int ai = 0; ai < 2; ++ai)
#pragma unroll
                for (int m = 0; m < 4; ++m) {
                    const f32x4 v0 = acc[ai][0][m][0] * acc[ai][1][m][0], v1 = acc[ai][0][m][1] * acc[ai][1][m][1];
                    u32x4 w; w.x = cvt_pk_bf16(v0[0], v0[1]); w.y = cvt_pk_bf16(v0[2], v0[3]); w.z = cvt_pk_bf16(v1[0], v1[1]); w.w = cvt_pk_bf16(v1[2], v1[3]);
                    *(u32x4*)(O + (size_t)(row0 + ai * HALF + m * 16) * D + colt + cl) = w;
                }
        } else if (mode == 1) {
#pragma unroll
            for (int ai = 0; ai < 2; ++ai) {
                f32x4 cs[4][4];
#pragma unroll
                for (int m = 0; m < 4; ++m) { const int pos = (row0 + ai * HALF + m * 16) & (SEQ - 1); const f32x4* rp = (const f32x4*)(rot + ((size_t)pos * 128 + cl) * 2);
#pragma unroll
                    for (int q = 0; q < 4; ++q) cs[m][q] = rp[q]; }
                asm volatile("" ::: "memory");
#pragma unroll
                for (int m = 0; m < 4; ++m) {
                    const int row = row0 + ai * HALF + m * 16;
                    const f32x4 c0 = cs[m][0], c1 = cs[m][1], c2 = cs[m][2], c3 = cs[m][3];
                    const f32x4 t1a = acc[ai][0][m][0], t1b = acc[ai][0][m][1], t2a = acc[ai][1][m][0], t2b = acc[ai][1][m][1];
                    u32x4 w1, w2;
                    w1.x = cvt_pk_bf16((t1a[0] * c0[0] - t2a[0] * c0[1]) * sc, (t1a[1] * c0[2] - t2a[1] * c0[3]) * sc);
                    w1.y = cvt_pk_bf16((t1a[2] * c1[0] - t2a[2] * c1[1]) * sc, (t1a[3] * c1[2] - t2a[3] * c1[3]) * sc);
                    w1.z = cvt_pk_bf16((t1b[0] * c2[0] - t2b[0] * c2[1]) * sc, (t1b[1] * c2[2] - t2b[1] * c2[3]) * sc);
                    w1.w = cvt_pk_bf16((t1b[2] * c3[0] - t2b[2] * c3[1]) * sc, (t1b[3] * c3[2] - t2b[3] * c3[3]) * sc);
                    w2.x = cvt_pk_bf16((t2a[0] * c0[0] + t1a[0] * c0[1]) * sc, (t2a[1] * c0[2] + t1a[1] * c0[3]) * sc);
                    w2.y = cvt_pk_bf16((t2a[2] * c1[0] + t1a[2] * c1[1]) * sc, (t2a[3] * c1[2] + t1a[3] * c1[3]) * sc);
                    w2.z = cvt_pk_bf16((t2b[0] * c2[0] + t1b[0] * c2[1]) * sc, (t2b[1] * c2[2] + t1b[1] * c2[3]) * sc);
                    w2.w = cvt_pk_bf16((t2b[2] * c3[0] + t1b[2] * c3[1]) * sc, (t2b[3] * c3[2] + t1b[3] * c3[3]) * sc);
                    bf16* rowp = O + (size_t)row * D + colt + cl;
                    *(u32x4*)rowp = w1; *(u32x4*)(rowp + HALF) = w2;
                }
                asm volatile("" ::: "memory");
            }
        } else {
#pragma unroll
            for (int ai = 0; ai < 2; ++ai)
#pragma unroll
                for (int m = 0; m < 4; ++m) {
                    bf16* rowp = O + (size_t)(row0 + ai * HALF + m * 16) * ldc + colt + cl;
#pragma unroll
                    for (int bj = 0; bj < 2; ++bj) {
                        f32x4 v0 = acc[ai][bj][m][0], v1 = acc[ai][bj][m][1];
                        if (mode == 0) { v0 = v0 * sc; v1 = v1 * sc; }
                        else if (mode == 2) {
#pragma unroll
                            for (int j = 0; j < 4; ++j) { v0[j] = silu_f(v0[j]); v1[j] = silu_f(v1[j]); } }
                        else {
#pragma unroll
                            for (int j = 0; j < 4; ++j) { v0[j] = sigmoid_f(v0[j]); v1[j] = sigmoid_f(v1[j]); } }
                        u32x4 w; w.x = cvt_pk_bf16(v0[0], v0[1]); w.y = cvt_pk_bf16(v0[2], v0[3]); w.z = cvt_pk_bf16(v1[0], v1[1]); w.w = cvt_pk_bf16(v1[2], v1[3]);
                        *(u32x4*)(rowp + bj * HALF) = w;
                    }
                }
        }
    }
};
struct EpiMerge {
    static constexpr bool PERM = true, HAS_MID = true;
    const bf16* gates;
    bf16* O;
    __device__ __forceinline__ void ld8(int plane, size_t off, f32x4& lo, f32x4& hi) const {
        const u32x4 w = *(const u32x4*)(gates + (size_t)plane * (PLANE / 2) + off);
        lo = (f32x4){bf_lo(w.x), bf_hi(w.x), bf_lo(w.y), bf_hi(w.y)}; hi = (f32x4){bf_lo(w.z), bf_hi(w.z), bf_lo(w.w), bf_hi(w.w)};
    }
    __device__ __forceinline__ u32x4 ldg(int plane, size_t off) const { return *(const u32x4*)(gates + (size_t)plane * (PLANE / 2) + off); }
    static __device__ __forceinline__ void unpack(const u32x4 w, f32x4& lo, f32x4& hi) {
        lo = (f32x4){bf_lo(w.x), bf_hi(w.x), bf_lo(w.y), bf_hi(w.y)}; hi = (f32x4){bf_lo(w.z), bf_hi(w.z), bf_lo(w.w), bf_hi(w.w)}; }
    __device__ __forceinline__ void mid(Acc& acc, const Unit& u, int which, int wr, int wc, int fr, int fq) const {
        const int pnum = which == 1 ? 1 : 2, pden = which == 1 ? 2 : 0;
        const int row0 = u.pm * BM + wr * 64 + fr, col0 = u.pn * BM + wc * 32 + 8 * fq;
#pragma unroll
        for (int ai = 0; ai < 2; ++ai) {
            u32x4 wn[4][2], wd[4][2];
#pragma unroll
            for (int m = 0; m < 4; ++m) { const size_t off = (size_t)(row0 + ai * HALF + m * 16) * D + col0;
#pragma unroll
                for (int bj = 0; bj < 2; ++bj) { wn[m][bj] = ldg(pnum, off + bj * HALF); wd[m][bj] = ldg(pden, off + bj * HALF); } }
            asm volatile("" ::: "memory");
#pragma unroll
            for (int m = 0; m < 4; ++m)
#pragma unroll
                for (int bj = 0; bj < 2; ++bj) {
                    f32x4 nl, nh, dl, dh; unpack(wn[m][bj], nl, nh); unpack(wd[m][bj], dl, dh);
#pragma unroll
                    for (int j = 0; j < 4; ++j) { acc[ai][bj][m][0][j] *= nl[j] * __builtin_amdgcn_rcpf(dl[j]); acc[ai][bj][m][1][j] *= nh[j] * __builtin_amdgcn_rcpf(dh[j]); }
                }
            asm volatile("" ::: "memory");
        }
    }
    __device__ __forceinline__ void operator()(const Acc& acc, const Unit& u, int wr, int wc, int fr, int fq) const {
        const int row0 = u.pm * BM + wr * 64 + fr, col0 = u.pn * BM + wc * 32 + 8 * fq;
#pragma unroll
        for (int ai = 0; ai < 2; ++ai) {
            u32x4 wg[4][2];
#pragma unroll
            for (int m = 0; m < 4; ++m) { const size_t off = (size_t)(row0 + ai * HALF + m * 16) * D + col0;
#pragma unroll
                for (int bj = 0; bj < 2; ++bj) wg[m][bj] = ldg(0, off + bj * HALF); }
            asm volatile("" ::: "memory");
#pragma unroll
            for (int m = 0; m < 4; ++m) { const size_t off = (size_t)(row0 + ai * HALF + m * 16) * D + col0;
#pragma unroll
                for (int bj = 0; bj < 2; ++bj) {
                    f32x4 gl, gh; unpack(wg[m][bj], gl, gh);
                    const f32x4 v0 = acc[ai][bj][m][0] * gl, v1 = acc[ai][bj][m][1] * gh;
                    u32x4 w; w.x = cvt_pk_bf16(v0[0], v0[1]); w.y = cvt_pk_bf16(v0[2], v0[3]); w.z = cvt_pk_bf16(v1[0], v1[1]); w.w = cvt_pk_bf16(v1[2], v1[3]);
                    *(u32x4*)(O + off + bj * HALF) = w;
                } }
            asm volatile("" ::: "memory");
        }
    }
};

template <class Epi>
__device__ __forceinline__ void gemm_phase(LAS unsigned char* lds, const Gemm g, const StaticOrder& S, const Epi& E, const int tid) {
    const int wid = __builtin_amdgcn_readfirstlane(tid >> 6), lane = tid & 63, wr = wid >> 2, wc = wid & 3, fr = lane & 15, fq = lane >> 4;
    const int K = g.K, nt = K / BK, lda = g.lda, segMask = (1 << g.segShift) - 1;
    unsigned voffA[2], voffB[2];
#pragma unroll
    for (int i = 0; i < 2; ++i) { int R, C; stage_rc(tid * 16 + i * 8192, R, C); const int Rb = Epi::PERM ? ((R & ~31) + perm32(R & 31)) : R;
        voffA[i] = (unsigned)(R * lda + C) * 2u; voffB[i] = (unsigned)(Rb * K + C) * 2u; }
    const size_t kstep = (size_t)(BK * 2);
    const size_t hstepA = (size_t)HALF * lda * 2, tstepA = 2 * hstepA;
    const size_t hstepB = (size_t)HALF * K * 2, tstepB = 2 * hstepB;
    const unsigned ldsw = (unsigned)wid * 1024u;
    const int aoff = lds_byte(wr * 64 + fr, fq * 8), boff = lds_byte(wc * 32 + fr, fq * 8);
#define PG8_KOFFA(t) ((size_t)((t) >> g.segShift) * g.segStride + (size_t)((t) & segMask) * kstep)
#define PG8_SA(b, h) (((b) * 2 + (h)) * HTB)
#define PG8_SB(b, h) ((4 + (b) * 2 + (h)) * HTB)
#define PG8_STAGE(bufoff, gbase, voff) do { _Pragma("unroll") for (int _i = 0; _i < 2; ++_i) \
        __builtin_amdgcn_global_load_lds((const unsigned*)((const char*)(gbase) + (voff)[_i]), (LAS unsigned*)(lds + (bufoff) + ldsw + _i * 8192), 16, 0, 0); } while (0)
#define PG8_LDA(dst, b, h) do { _Pragma("unroll") for (int m = 0; m < 4; ++m) _Pragma("unroll") for (int k = 0; k < 2; ++k) dst[m][k] = *(const LAS bf16x8*)(lds + PG8_SA(b, h) + aoff + m * 2048 + k * 1024); } while (0)
#define PG8_LDB(dst, b, h) do { _Pragma("unroll") for (int n = 0; n < 2; ++n) _Pragma("unroll") for (int k = 0; k < 2; ++k) dst[n][k] = *(const LAS bf16x8*)(lds + PG8_SB(b, h) + boff + n * 2048 + k * 1024); } while (0)
#define PG8_MMA(ai, bj, At, Bt) do { __builtin_amdgcn_s_setprio(1); _Pragma("unroll") for (int m = 0; m < 4; ++m) _Pragma("unroll") for (int n = 0; n < 2; ++n) _Pragma("unroll") for (int k = 0; k < 2; ++k) \
        acc[ai][bj][m][n] = __builtin_amdgcn_mfma_f32_16x16x32_bf16(Bt[n][k], At[m][k], acc[ai][bj][m][n], 0, 0, 0); __builtin_amdgcn_s_setprio(0); } while (0)
#define PG8_WAIT_V(n) asm volatile("s_waitcnt vmcnt(" #n ")" ::: "memory")
#define PG8_WAIT_L(n) asm volatile("s_waitcnt lgkmcnt(" #n ")" ::: "memory")
#define PG8_BAR __builtin_amdgcn_s_barrier()
#define PG8_SCHED __builtin_amdgcn_sched_barrier(0)
    Unit cur, nxt; int ui = 0;
    if (!S.next(0, cur)) return;
    Acc acc;
#pragma unroll
    for (int a = 0; a < 2; ++a)
#pragma unroll
        for (int b = 0; b < 2; ++b)
#pragma unroll
            for (int m = 0; m < 4; ++m)
#pragma unroll
                for (int n = 0; n < 2; ++n) acc[a][b][m][n] = (f32x4){0.f, 0.f, 0.f, 0.f};
    bf16x8 At[4][2], B0[2][2], B1[2][2];
    const char* cA = (const char*)g.A + (size_t)cur.pm * tstepA; const char* cB = (const char*)g.Bt + (size_t)cur.pn * tstepB;
    PG8_STAGE(PG8_SB(0, 0), cB, voffB); PG8_STAGE(PG8_SB(0, 1), cB + hstepB, voffB); PG8_STAGE(PG8_SA(0, 0), cA, voffA); PG8_STAGE(PG8_SA(0, 1), cA + hstepA, voffA);
    if (wr == 1) PG8_BAR;
    PG8_WAIT_V(2); PG8_BAR;
    PG8_STAGE(PG8_SB(1, 0), cB + kstep, voffB); PG8_STAGE(PG8_SA(1, 0), cA + kstep, voffA); PG8_STAGE(PG8_SB(1, 1), cB + hstepB + kstep, voffB);
    PG8_WAIT_V(6); PG8_BAR;
    for (;;) {
        const bool has_next = S.next(ui + 1, nxt);
        const char* nA = has_next ? (const char*)g.A + (size_t)nxt.pm * tstepA : cA; const char* nB = has_next ? (const char*)g.Bt + (size_t)nxt.pn * tstepB : cB;
        for (int t = 0; t < nt; t += 2) {
            const bool last = (t == nt - 2);
            const char* a1 = cA + PG8_KOFFA(t + 1);
            const char* a2 = last ? nA : cA + PG8_KOFFA(t + 2); const char* b2 = last ? nB : cB + (size_t)(t + 2) * kstep;
            const char* a3 = a2 + kstep; const char* b3 = b2 + kstep;
            PG8_LDB(B0, 0, 0); PG8_LDB(B1, 0, 1); PG8_SCHED; PG8_LDA(At, 0, 0); PG8_STAGE(PG8_SA(1, 1), a1 + hstepA, voffA);
            PG8_WAIT_V(8); PG8_WAIT_L(0); PG8_BAR; PG8_MMA(0, 0, At, B0); PG8_MMA(0, 1, At, B1); PG8_BAR; PG8_SCHED;
            PG8_LDA(At, 0, 1); PG8_STAGE(PG8_SB(0, 0), b2, voffB); PG8_STAGE(PG8_SB(0, 1), b2 + hstepB, voffB); PG8_STAGE(PG8_SA(0, 0), a2, voffA);
            PG8_WAIT_V(8); PG8_WAIT_L(0); PG8_BAR; PG8_MMA(1, 0, At, B0); PG8_MMA(1, 1, At, B1); PG8_BAR; PG8_SCHED;
            PG8_LDB(B0, 1, 0); PG8_LDB(B1, 1, 1); PG8_SCHED; PG8_LDA(At, 1, 0); PG8_STAGE(PG8_SA(0, 1), a2 + hstepA, voffA);
            PG8_WAIT_V(8); PG8_WAIT_L(0); PG8_BAR; PG8_MMA(0, 0, At, B0); PG8_MMA(0, 1, At, B1); PG8_BAR; PG8_SCHED;
            PG8_LDA(At, 1, 1); PG8_STAGE(PG8_SB(1, 0), b3, voffB); PG8_STAGE(PG8_SB(1, 1), b3 + hstepB, voffB); PG8_STAGE(PG8_SA(1, 0), a3, voffA);
            PG8_WAIT_V(8); PG8_WAIT_L(0); PG8_BAR; PG8_MMA(1, 0, At, B0); PG8_MMA(1, 1, At, B1); PG8_BAR; PG8_SCHED;
            if constexpr (Epi::HAS_MID) { if (!last && ((t + 2) & 15) == 0) { int fr_ = fr, fq_ = fq; asm volatile("" : "+v"(fr_), "+v"(fq_)); E.mid(acc, cur, (t + 2) >> 4, wr, wc, fr_, fq_); PG8_SCHED; } }
        }
        if (wr == 0) PG8_BAR;
        { int fr_ = fr, fq_ = fq; asm volatile("" : "+v"(fr_), "+v"(fq_)); E(acc, cur, wr, wc, fr_, fq_); }
        if (!has_next) break;
#pragma unroll
        for (int a = 0; a < 2; ++a)
#pragma unroll
            for (int b = 0; b < 2; ++b)
#pragma unroll
                for (int m = 0; m < 4; ++m)
#pragma unroll
                    for (int n = 0; n < 2; ++n) acc[a][b][m][n] = (f32x4){0.f, 0.f, 0.f, 0.f};
        cur = nxt; cA = nA; cB = nB; ++ui;
        if (wr == 1) PG8_BAR;
    }
    PG8_WAIT_V(0);
    PG8_BAR;
#undef PG8_KOFFA
#undef PG8_SA
#undef PG8_SB
#undef PG8_STAGE
#undef PG8_LDA
#undef PG8_LDB
#undef PG8_MMA
#undef PG8_WAIT_V
#undef PG8_WAIT_L
#undef PG8_BAR
#undef PG8_SCHED
}
}

__device__ __forceinline__ void transpose_item(const float* W, int N, int k0, int n0, bf16* WT, int Kd, int drow0, int dcol0, LAS float* scr, int lane) {
    float tv[32];
#pragma unroll
    for (int i = 0; i < 32; ++i) { const int kk = 2 * i + (lane >> 5); tv[i] = W[(size_t)(k0 + kk) * N + n0 + (lane & 31)]; }
#pragma unroll
    for (int i = 0; i < 32; ++i) { const int kk = 2 * i + (lane >> 5); scr[kk * 33 + (lane & 31)] = tv[i]; }
    if (0) for (int i = 0; i < 32; ++i) { const int kk = 2 * i + (lane >> 5); scr[kk * 33 + (lane & 31)] = W[(size_t)(k0 + kk) * N + n0 + (lane & 31)]; }
    LDS_WAIT();
    const int c = lane & 7;
#pragma unroll
    for (int j = 0; j < 4; ++j) { const int n = (lane >> 3) + 8 * j; const LAS float* s = scr + (8 * c) * 33 + n;
        u32x4 o; o.x = cvt_pk_bf16(s[0 * 33], s[1 * 33]); o.y = cvt_pk_bf16(s[2 * 33], s[3 * 33]); o.z = cvt_pk_bf16(s[4 * 33], s[5 * 33]); o.w = cvt_pk_bf16(s[6 * 33], s[7 * 33]);
        *(u32x4*)(WT + (size_t)(drow0 + n) * Kd + dcol0 + k0 + 8 * c) = o; }
    LDS_WAIT();
}
__device__ __forceinline__ void convert_ffn(const float* w1, const float* w3, const float* w2, unsigned char* ws, LAS float* scr, int gw, int ngw, int lane) {
    bf16* W13 = (bf16*)(ws + W_W13); bf16* W2 = (bf16*)(ws + W_W2);
    for (int it = gw; it < 4224; it += ngw) {
        if (it < 2816) { const int sel = it >= 1408, r = it - sel * 1408, kb = r / 88, nb = r % 88, n0 = 32 * nb;
            transpose_item(sel ? w3 : w1, DFF, 64 * kb, n0, W13, D, 256 * (n0 >> 7) + 128 * sel + (n0 & 127), 0, scr, lane); }
        else { const int r = it - 2816, kb = r / 32, nb = r % 32; transpose_item(w2, D, 64 * kb, 32 * nb, W2, DFF, 32 * nb, 0, scr, lane); }
    }
}
__device__ __forceinline__ void convert_mixer(const float* w_in, const float* p_ret, const float* p_conv, const float* p_swa, const float* w_out, unsigned char* ws, LAS float* scr, int gw, int ngw, int lane) {
    bf16* WIN = (bf16*)(ws + W_IN); bf16* PC = (bf16*)(ws + W_PCAT); bf16* WO = (bf16*)(ws + W_OUT);
    for (int it = gw; it < 7808; it += ngw) {
        if (it < 5760) { const int kb = it / 360, nb = it % 360, n0 = 32 * nb; int dr = n0;
            if (n0 >= 5120 && n0 < 6144) { const int ch = n0 - 5120; dr = 5120 + 256 * (ch >> 7) + (ch & 127); }
            else if (n0 >= 6144 && n0 < 7168) { const int ch = n0 - 6144; dr = 5120 + 256 * (ch >> 7) + 128 + (ch & 127); }
            transpose_item(w_in, INC, 64 * kb, n0, WIN, D, dr, 0, scr, lane); }
        else if (it < 7296) { const int r = it - 5760, sel = r / 512, q = r % 512, kb = q / 32, nb = q % 32;
            transpose_item(sel == 0 ? p_conv : (sel == 1 ? p_swa : p_ret), D, 64 * kb, 32 * nb, PC, 3 * D, 32 * nb, sel * D, scr, lane); }
        else { const int q = it - 7296, kb = q / 32, nb = q % 32; transpose_item(w_out, D, 64 * kb, 32 * nb, WO, D, 32 * nb, 0, scr, lane); }
    }
}
__device__ __forceinline__ void norm_rows(const void* hin, const int in_bf16, const float* gain, const float* sh, const float* sc, bf16* U, int gw, int ngw, int lane) {
    for (int blk = gw; blk < M / 16; blk += ngw) {
        const int r0 = blk * 16, b = r0 >> 12;
        f32x4 gm[4], sv[4];
#pragma unroll
        for (int j = 0; j < 4; ++j) { const int col = 4 * (64 * j + lane); const f32x4 g4 = *(const f32x4*)(gain + col), s4 = *(const f32x4*)(sc + (size_t)b * MODW + col);
            gm[j] = g4 * (s4 + 1.0f); sv[j] = *(const f32x4*)(sh + (size_t)b * MODW + col); }
        for (int r = r0; r < r0 + 16; r += 4) {
            f32x4 v[4][4]; float s[4];
#pragma unroll
            for (int q = 0; q < 4; ++q) {
                if (in_bf16) { const u32x2* xb = (const u32x2*)((const bf16*)hin + (size_t)(r + q) * D) + lane;
#pragma unroll
                    for (int j = 0; j < 4; ++j) { const u32x2 w = xb[64 * j]; v[q][j] = (f32x4){bf_lo(w.x), bf_hi(w.x), bf_lo(w.y), bf_hi(w.y)}; } }
                else { const f32x4* xr = (const f32x4*)((const float*)hin + (size_t)(r + q) * D) + lane;
#pragma unroll
                    for (int j = 0; j < 4; ++j) v[q][j] = xr[64 * j]; } }
#pragma unroll
            for (int q = 0; q < 4; ++q) { s[q] = 0.f;
#pragma unroll
                for (int j = 0; j < 4; ++j) s[q] += (v[q][j][0] * v[q][j][0] + v[q][j][1] * v[q][j][1]) + (v[q][j][2] * v[q][j][2] + v[q][j][3] * v[q][j][3]); }
#pragma unroll
            for (int o = 1; o < 64; o <<= 1) {
#pragma unroll
                for (int q = 0; q < 4; ++q) s[q] += __shfl_xor(s[q], o); }
#pragma unroll
            for (int q = 0; q < 4; ++q) { const float rstd = 1.0f / sqrtf(s[q] * (1.0f / D) + EPS);
                u32x2* o8 = (u32x2*)(U + (size_t)(r + q) * D) + lane;
#pragma unroll
                for (int j = 0; j < 4; ++j) { const f32x4 y = v[q][j] * rstd * gm[j] + sv[j]; u32x2 w; w.x = cvt_pk_bf16(y[0], y[1]); w.y = cvt_pk_bf16(y[2], y[3]); o8[64 * j] = w; } }
        }
    }
}
__device__ __forceinline__ void final_norm_rows(const float* h, float* outp, const float* gain, int gw, int ngw, int lane) {
    f32x4 gm[4];
#pragma unroll
    for (int j = 0; j < 4; ++j) gm[j] = *(const f32x4*)(gain + 4 * (64 * j + lane));
    for (int r0 = gw * 4; r0 < M; r0 += ngw * 4) {
        f32x4 v[4][4]; float s[4];
#pragma unroll
        for (int q = 0; q < 4; ++q) { const f32x4* xr = (const f32x4*)(h + (size_t)(r0 + q) * D) + lane;
#pragma unroll
            for (int j = 0; j < 4; ++j) v[q][j] = xr[64 * j]; }
#pragma unroll
        for (int q = 0; q < 4; ++q) { s[q] = 0.f;
#pragma unroll
            for (int j = 0; j < 4; ++j) s[q] += (v[q][j][0] * v[q][j][0] + v[q][j][1] * v[q][j][1]) + (v[q][j][2] * v[q][j][2] + v[q][j][3] * v[q][j][3]); }
#pragma unroll
        for (int o = 1; o < 64; o <<= 1) {
#pragma unroll
            for (int q = 0; q < 4; ++q) s[q] += __shfl_xor(s[q], o); }
#pragma unroll
        for (int q = 0; q < 4; ++q) { const float rstd = 1.0f / sqrtf(s[q] * (1.0f / D) + EPS); f32x4* xw = (f32x4*)(outp + (size_t)(r0 + q) * D) + lane;
#pragma unroll
            for (int j = 0; j < 4; ++j) xw[64 * j] = v[q][j] * rstd * gm[j]; }
    }
}
__device__ __forceinline__ void p0_phase(LAS unsigned char* lds, const float* c, const float* ada_w, const float* ada_b, unsigned char* ws, int vcu, int G, int tid, int lane, int wave) {
    LAS float* cact = (LAS float*)lds; LAS float* red = (LAS float*)(lds + 32768);
    for (int i = tid; i < BATCH * D; i += 512) cact[i] = silu_f(c[i]);
    WG_BAR();
    float* mod = (float*)(ws + WS_MOD);
    for (int item = vcu; item < 288; item += G) {
        const int l = item / 144, cb = item % 144;
        const float* W = ada_w + (size_t)l * D * MODW + 64 * cb + lane;
        float a[8];
#pragma unroll
        for (int b = 0; b < 8; ++b) a[b] = 0.f;
#pragma unroll 16
        for (int k = 128 * wave; k < 128 * wave + 128; ++k) { const float w = W[(size_t)k * MODW];
#pragma unroll
            for (int b = 0; b < 8; ++b) a[b] += cact[b * D + k] * w; }
#pragma unroll
        for (int b = 0; b < 8; ++b) red[(wave * 8 + b) * 64 + lane] = a[b];
        WG_BAR();
        { const int b = wave; float s = ada_b[(size_t)l * MODW + 64 * cb + lane];
#pragma unroll
            for (int wv = 0; wv < 8; ++wv) s += red[(wv * 8 + b) * 64 + lane];
            mod[((size_t)l * 8 + b) * MODW + 64 * cb + lane] = s; }
        WG_BAR();
    }
    f32x2* rot = (f32x2*)(ws + WS_ROT);
    for (int e = vcu * 512 + tid; e < SEQ * 128; e += G * 512) {
        const int pos = e >> 7, j = e & 127;
        const float lin = (float)j / 127.0f;
        const float inv = exp2f(-lin * 13.287712379549449f);
        const float ang = (float)pos * inv;
        float sn, cs; sincosf(ang, &sn, &cs);
        rot[e] = (f32x2){cs, sn};
    }
}

__device__ __forceinline__ void scan_phase(LAS unsigned char* lds, const bf16* RQ, const bf16* RK, const bf16* RV, bf16* RO, float* ssq, int vcu, int tid, int lane, int wave, const int pmode = 0) {
    constexpr int KROW = 528, VROW = 80, SROW = 528;
    LAS unsigned char* Ks = lds; LAS unsigned char* Vs = lds + 67584; LAS unsigned char* Vzs = Vs + 10240; LAS unsigned char* Ss0 = Vzs + 10240; LAS unsigned char* Ss1 = Ss0 + 16896;
    const int p = vcu >> 3, s = vcu & 7, b = p >> 2, h = p & 3;
    const int g = lane >> 4, c16 = lane & 15, q4 = (lane >> 2) & 3, p4 = lane & 3;
    const float lg = log2f(1.0f - exp2f(-5.0f - (float)h));
    const size_t tokbase = (size_t)b * SEQ;
    for (int i = tid; i < 16896 / 4; i += 512) ((LAS unsigned*)Ss0)[i] = 0u;
    f32x4 accS[2][2];
#pragma unroll
    for (int a = 0; a < 2; ++a)
#pragma unroll
        for (int c = 0; c < 2; ++c) accS[a][c] = (f32x4){0.f, 0.f, 0.f, 0.f};
    u32x4 kreg[8]; u32x4 vreg; bf16x8 qn[8];
    const int vrow = tid >> 2, vc16 = tid & 3;
#define SCAN_LOAD(n) do { const size_t t0_ = tokbase + (size_t)(n) * 128; \
        _Pragma("unroll") for (int i_ = 0; i_ < 8; ++i_) { const int c_ = tid + 512 * i_; kreg[i_] = *(const u32x4*)(RK + (t0_ + (c_ >> 5)) * D + 256 * h + (c_ & 31) * 8); } \
        vreg = *(const u32x4*)(RV + (t0_ + vrow) * D + 256 * h + 32 * s + vc16 * 8); \
        _Pragma("unroll") for (int ks_ = 0; ks_ < 8; ++ks_) qn[ks_] = *(const bf16x8*)(RQ + (t0_ + 16 * wave + c16) * D + 256 * h + 32 * ks_ + 8 * g); } while (0)
    SCAN_LOAD(0);
    int cur = 0;
    for (int n = 0; n < 32; ++n) {
        WG_BAR();
#pragma unroll
        for (int i = 0; i < 8; ++i) { const int c = tid + 512 * i; *(LAS u32x4*)(Ks + (c >> 5) * KROW + (c & 31) * 16) = kreg[i]; }
        *(LAS u32x4*)(Vs + vrow * VROW + vc16 * 16) = vreg;
        { const float z = exp2f(lg * (float)(127 - vrow)); u32x4 w;
            w.x = cvt_pk_bf16(bf_lo(vreg.x) * z, bf_hi(vreg.x) * z); w.y = cvt_pk_bf16(bf_lo(vreg.y) * z, bf_hi(vreg.y) * z);
            w.z = cvt_pk_bf16(bf_lo(vreg.z) * z, bf_hi(vreg.z) * z); w.w = cvt_pk_bf16(bf_lo(vreg.w) * z, bf_hi(vreg.w) * z);
            *(LAS u32x4*)(Vzs + vrow * VROW + vc16 * 16) = w; }
        bf16x8 qc[8];
#pragma unroll
        for (int ks = 0; ks < 8; ++ks) qc[ks] = qn[ks];
        const size_t tok0 = tokbase + (size_t)n * 128;
        if (n + 1 < 32 && !(pmode & 1)) SCAN_LOAD(n + 1);
        WG_BAR();
        LAS unsigned char* Sc = cur ? Ss1 : Ss0; LAS unsigned char* Sn = cur ? Ss0 : Ss1;
        const int i_loc = 16 * wave + c16;
        f32x4 accX[2], accI[2];
#pragma unroll
        for (int mt = 0; mt < 2; ++mt) { accX[mt] = (f32x4){0.f, 0.f, 0.f, 0.f}; accI[mt] = (f32x4){0.f, 0.f, 0.f, 0.f}; }
        {
#pragma unroll
            for (int kh = 0; kh < 4; ++kh) {
                bf16x8 fa[4];
#pragma unroll
                for (int k4 = 0; k4 < 2; ++k4)
#pragma unroll
                    for (int mt = 0; mt < 2; ++mt) fa[2 * k4 + mt] = *(const LAS bf16x8*)(Sc + (16 * mt + c16) * SROW + (32 * (2 * kh + k4) + 8 * g) * 2);
                asm volatile("" ::: "memory");
#pragma unroll
                for (int k4 = 0; k4 < 2; ++k4)
#pragma unroll
                    for (int mt = 0; mt < 2; ++mt) accX[mt] = mfma16(fa[2 * k4 + mt], qc[2 * kh + k4], accX[mt]);
            }
        }
        const int nkb = (pmode & 2) ? 0 : (wave >> 1) + 1;
        for (int kb = 0; kb < nkb; ++kb) {
            f32x4 st[2]; s16x4 vlo[2], vhi[2];
#pragma unroll
            for (int t = 0; t < 2; ++t) st[t] = (f32x4){0.f, 0.f, 0.f, 0.f};
#pragma unroll
            for (int kh = 0; kh < 4; ++kh) {
                bf16x8 fk[4];
#pragma unroll
                for (int k4 = 0; k4 < 2; ++k4)
#pragma unroll
                    for (int t = 0; t < 2; ++t) fk[2 * k4 + t] = *(const LAS bf16x8*)(Ks + (16 * (2 * kb + t) + c16) * KROW + (32 * (2 * kh + k4) + 8 * g) * 2);
                asm volatile("" ::: "memory");
#pragma unroll
                for (int k4 = 0; k4 < 2; ++k4)
#pragma unroll
                    for (int t = 0; t < 2; ++t) st[t] = mfma16(fk[2 * k4 + t], qc[2 * kh + k4], st[t]);
            }
            float pv[2][4];
#pragma unroll
            for (int t = 0; t < 2; ++t)
#pragma unroll
                for (int r = 0; r < 4; ++r) { const int d = i_loc - (16 * (2 * kb + t) + 4 * g + r); pv[t][r] = d >= 0 ? st[t][r] * __builtin_amdgcn_exp2f(lg * (float)d) : 0.f; }
            u32x4 pw; pw.x = cvt_pk_bf16(pv[0][0], pv[0][1]); pw.y = cvt_pk_bf16(pv[0][2], pv[0][3]); pw.z = cvt_pk_bf16(pv[1][0], pv[1][1]); pw.w = cvt_pk_bf16(pv[1][2], pv[1][3]);
            const bf16x8 pb = __builtin_bit_cast(bf16x8, pw);
#pragma unroll
            for (int mt = 0; mt < 2; ++mt) { vlo[mt] = tr_read(Vs + (32 * kb + 4 * g + q4) * VROW + (16 * mt + 4 * p4) * 2); vhi[mt] = tr_read(Vs + (32 * kb + 16 + 4 * g + q4) * VROW + (16 * mt + 4 * p4) * 2); }
#pragma unroll
            for (int mt = 0; mt < 2; ++mt) accI[mt] = mfma16(cat4(vlo[mt], vhi[mt]), pb, accI[mt]);
        }
        {
            const float xi = exp2f(lg * (float)(i_loc + 1)); float ss = 0.f;
#pragma unroll
            for (int mt = 0; mt < 2; ++mt) { const f32x4 o = accI[mt] + accX[mt] * xi; ss += (o[0] * o[0] + o[1] * o[1]) + (o[2] * o[2] + o[3] * o[3]);
                u32x2 w; w.x = cvt_pk_bf16(o[0], o[1]); w.y = cvt_pk_bf16(o[2], o[3]);
                *(u32x2*)(RO + (tok0 + i_loc) * D + 256 * h + 32 * s + 16 * mt + 4 * g) = w; }
            ss += __shfl_xor(ss, 16); ss += __shfl_xor(ss, 32);
            if (g == 0 && pmode == 0) ssq[((tok0 + i_loc) * 4 + h) * 8 + s] = ss;
        }
        {
            const float decay = exp2f(lg * 128.0f);
#pragma unroll
            for (int mt = 0; mt < 2; ++mt)
#pragma unroll
                for (int nt = 0; nt < 2; ++nt) accS[mt][nt] = accS[mt][nt] * decay;
#pragma unroll
            for (int k4 = 0; k4 < 4; ++k4) {
                bf16x8 Af[2], Bf[2];
#pragma unroll
                for (int mt = 0; mt < 2; ++mt) Af[mt] = cat4(tr_read(Vzs + (32 * k4 + 8 * g + q4) * VROW + (16 * mt + 4 * p4) * 2), tr_read(Vzs + (32 * k4 + 8 * g + 4 + q4) * VROW + (16 * mt + 4 * p4) * 2));
#pragma unroll
                for (int nt = 0; nt < 2; ++nt) Bf[nt] = cat4(tr_read(Ks + (32 * k4 + 8 * g + q4) * KROW + (32 * wave + 16 * nt + 4 * p4) * 2), tr_read(Ks + (32 * k4 + 8 * g + 4 + q4) * KROW + (32 * wave + 16 * nt + 4 * p4) * 2));
#pragma unroll
                for (int mt = 0; mt < 2; ++mt)
#pragma unroll
                    for (int nt = 0; nt < 2; ++nt) accS[mt][nt] = mfma16(Af[mt], Bf[nt], accS[mt][nt]);
            }
#pragma unroll
            for (int mt = 0; mt < 2; ++mt)
#pragma unroll
                for (int nt = 0; nt < 2; ++nt)
#pragma unroll
                    for (int r = 0; r < 4; ++r) *(LAS bf16*)(Sn + (16 * mt + 4 * g + r) * SROW + (32 * wave + 16 * nt + c16) * 2) = (bf16)(cvt_pk_bf16(accS[mt][nt][r], 0.f) & 0xffffu);
        }
        cur ^= 1;
    }
#undef SCAN_LOAD
    WG_BAR();
}

struct ConvRegs { u32x4 z0[2], z1[2], z2[2], cb[2]; };
__device__ __forceinline__ void conv_load(const bf16* CB, const bf16* Z, int idx, int nthr, int c8, ConvRegs& r) {
#pragma unroll
    for (int u = 0; u < 2; ++u) { const int t = (idx + u * nthr) >> 7, pos = t & (SEQ - 1);
        r.z0[u] = *(const u32x4*)(Z + (size_t)t * D + 8 * c8);
        r.z1[u] = (u32x4){0u, 0u, 0u, 0u}; r.z2[u] = (u32x4){0u, 0u, 0u, 0u};
        if (pos >= 1) r.z1[u] = *(const u32x4*)(Z + (size_t)(t - 1) * D + 8 * c8);
        if (pos >= 2) r.z2[u] = *(const u32x4*)(Z + (size_t)(t - 2) * D + 8 * c8);
        r.cb[u] = *(const u32x4*)(CB + (size_t)t * D + 8 * c8); }
}
__device__ __forceinline__ void conv_finish(bf16* Yb, const f32x4 (&cwv)[6], int idx, int nthr, int c8, const ConvRegs& r) {
#pragma unroll
    for (int u = 0; u < 2; ++u) { const int t = (idx + u * nthr) >> 7;
        float y[8];
        const unsigned zz0[4] = {r.z0[u].x, r.z0[u].y, r.z0[u].z, r.z0[u].w}, zz1[4] = {r.z1[u].x, r.z1[u].y, r.z1[u].z, r.z1[u].w}, zz2[4] = {r.z2[u].x, r.z2[u].y, r.z2[u].z, r.z2[u].w}, cc[4] = {r.cb[u].x, r.cb[u].y, r.cb[u].z, r.cb[u].w};
#pragma unroll
        for (int k = 0; k < 4; ++k) {
            const float wa0 = k < 2 ? cwv[0][2 * k] : cwv[1][2 * k - 4], wb0 = k < 2 ? cwv[0][2 * k + 1] : cwv[1][2 * k - 3];
            const float wa1 = k < 2 ? cwv[2][2 * k] : cwv[3][2 * k - 4], wb1 = k < 2 ? cwv[2][2 * k + 1] : cwv[3][2 * k - 3];
            const float wa2 = k < 2 ? cwv[4][2 * k] : cwv[5][2 * k - 4], wb2 = k < 2 ? cwv[4][2 * k + 1] : cwv[5][2 * k - 3];
            y[2 * k] = bf_lo(cc[k]) * (wa0 * bf_lo(zz2[k]) + wa1 * bf_lo(zz1[k]) + wa2 * bf_lo(zz0[k]));
            y[2 * k + 1] = bf_hi(cc[k]) * (wb0 * bf_hi(zz2[k]) + wb1 * bf_hi(zz1[k]) + wb2 * bf_hi(zz0[k]));
        }
        u32x4 w; w.x = cvt_pk_bf16(y[0], y[1]); w.y = cvt_pk_bf16(y[2], y[3]); w.z = cvt_pk_bf16(y[4], y[5]); w.w = cvt_pk_bf16(y[6], y[7]);
        *(u32x4*)(Yb + (size_t)t * D + 8 * c8) = w; }
}
__device__ __forceinline__ void swa_phase(LAS unsigned char* lds, const bf16* SQ, const bf16* SKV, bf16* Yc, const float* sinks, int vcu, int G, int tid, int lane, int wave,
                                          const bool fuse, const bf16* CB, const bf16* Z, const float* cw, bf16* Yb, int gtid, int nthr) {
    const int cc8 = gtid & 127; int cit = 0;
    f32x4 cwv[6];
#pragma unroll
    for (int j = 0; j < 3; ++j) { cwv[2 * j] = *(const f32x4*)(cw + j * D + 8 * cc8); cwv[2 * j + 1] = *(const f32x4*)(cw + j * D + 8 * cc8 + 4); }
    constexpr int ROWB = 144;
    LAS unsigned char* Ks = lds; LAS unsigned char* Vs = lds + 256 * ROWB;
    const int g = lane >> 4, c16 = lane & 15, q4 = (lane >> 2) & 3, p4 = lane & 3;
    for (int unit = vcu; unit < 512; unit += G) {
        const int b = unit >> 6, nb = (unit >> 1) & 31, kvh = unit & 1;
        const size_t tok_cur = (size_t)b * SEQ + 128 * nb, tok_prev = nb > 0 ? tok_cur - 128 : tok_cur;
        const bf16* qsrc = SQ + (tok_cur + 16 * wave + c16) * D + 64 * (8 * kvh) + 8 * g;
        bf16x8 qn0 = *(const bf16x8*)(qsrc), qn1 = *(const bf16x8*)(qsrc + 32);
        u32x4 kr[4], vr[4];
        { const int row = tid >> 1, half = tid & 1; const size_t tok = row < 128 ? tok_prev + row : tok_cur + (row - 128);
            const bf16* src = SKV + tok * 256 + 64 * kvh + 32 * half;
#pragma unroll
            for (int i = 0; i < 4; ++i) { kr[i] = *(const u32x4*)(src + 8 * i); vr[i] = *(const u32x4*)(src + 128 + 8 * i); }
            WG_BAR();
#pragma unroll
            for (int i = 0; i < 4; ++i) { *(LAS u32x4*)(Ks + row * ROWB + half * 64 + 16 * i) = kr[i]; *(LAS u32x4*)(Vs + row * ROWB + half * 64 + 16 * i) = vr[i]; }
        }
        WG_BAR();
        const int jt0 = 2 * (wave >> 1), iq = 16 * wave + c16;
        for (int hq = 0; hq < 8; ++hq) {
            const float sink = sinks[8 * kvh + hq];
            const bf16x8 q0 = qn0, q1 = qn1;
            int iqm = iq; asm volatile("" : "+v"(iqm));
            ConvRegs cr; const bool doconv = fuse && cit < 16;
            if (doconv) conv_load(CB, Z, gtid + cit * 2 * nthr, nthr, cc8, cr);
            if (hq < 7) { qn0 = *(const bf16x8*)(qsrc + 64 * (hq + 1)); qn1 = *(const bf16x8*)(qsrc + 64 * (hq + 1) + 32); }
            f32x4 st[10];
#pragma unroll
            for (int hf = 0; hf < 2; ++hf) {
                bf16x8 fk[10];
#pragma unroll
                for (int t = 0; t < 5; ++t)
#pragma unroll
                    for (int ks = 0; ks < 2; ++ks) fk[2 * t + ks] = *(const LAS bf16x8*)(Ks + (16 * (jt0 + 5 * hf + t) + c16) * ROWB + (32 * ks + 8 * g) * 2);
                asm volatile("" ::: "memory");
#pragma unroll
                for (int t = 0; t < 5; ++t) { st[5 * hf + t] = mfma16(fk[2 * t], q0, (f32x4){0.f, 0.f, 0.f, 0.f}); st[5 * hf + t] = mfma16(fk[2 * t + 1], q1, st[5 * hf + t]); }
            }
            float mx = sink;
#pragma unroll
            for (int t = 0; t < 10; ++t)
#pragma unroll
                for (int r = 0; r < 4; ++r) { const int j = 16 * (jt0 + t) + 4 * g + r, d = iqm + 128 - j; const bool valid = (d >= 0) && (d < 128) && (nb > 0 || j >= 128);
                    st[t][r] = valid ? st[t][r] : -INFINITY; mx = fmaxf(mx, st[t][r]); }
            mx = fmaxf(mx, __shfl_xor(mx, 16)); mx = fmaxf(mx, __shfl_xor(mx, 32));
            float sum = 0.f;
#pragma unroll
            for (int t = 0; t < 10; ++t)
#pragma unroll
                for (int r = 0; r < 4; ++r) { st[t][r] = __builtin_amdgcn_exp2f((st[t][r] - mx) * LOG2E); sum += st[t][r]; }
            sum += __shfl_xor(sum, 16); sum += __shfl_xor(sum, 32);
            const float inv = 1.0f / (sum + __builtin_amdgcn_exp2f((sink - mx) * LOG2E));
            f32x4 o[4];
#pragma unroll
            for (int dt = 0; dt < 4; ++dt) o[dt] = (f32x4){0.f, 0.f, 0.f, 0.f};
#pragma unroll
            for (int kbi = 0; kbi < 5; ++kbi) {
                u32x4 pw; pw.x = cvt_pk_bf16(st[2 * kbi][0], st[2 * kbi][1]); pw.y = cvt_pk_bf16(st[2 * kbi][2], st[2 * kbi][3]);
                pw.z = cvt_pk_bf16(st[2 * kbi + 1][0], st[2 * kbi + 1][1]); pw.w = cvt_pk_bf16(st[2 * kbi + 1][2], st[2 * kbi + 1][3]);
                const bf16x8 pb = __builtin_bit_cast(bf16x8, pw);
                s16x4 lo[4], hi[4];
#pragma unroll
                for (int dt = 0; dt < 4; ++dt) { lo[dt] = tr_read(Vs + (16 * (jt0 + 2 * kbi) + 4 * g + q4) * ROWB + (16 * dt + 4 * p4) * 2); hi[dt] = tr_read(Vs + (16 * (jt0 + 2 * kbi + 1) + 4 * g + q4) * ROWB + (16 * dt + 4 * p4) * 2); }
                asm volatile("" ::: "memory");
#pragma unroll
                for (int dt = 0; dt < 4; ++dt) o[dt] = mfma16(cat4(lo[dt], hi[dt]), pb, o[dt]);
            }
#pragma unroll
            for (int dt = 0; dt < 4; ++dt) { u32x2 w; w.x = cvt_pk_bf16(o[dt][0] * inv, o[dt][1] * inv); w.y = cvt_pk_bf16(o[dt][2] * inv, o[dt][3] * inv);
                *(u32x2*)(Yc + (tok_cur + iq) * D + 64 * (8 * kvh + hq) + 16 * dt + 4 * g) = w; }
            if (doconv) conv_finish(Yb, cwv, gtid + cit * 2 * nthr, nthr, cc8, cr);
            ++cit;
        }
    }
    WG_BAR();
}
__device__ __forceinline__ void ya_pass(const bf16* R, const bf16* RG, const float* ssq, bf16* Ya, int gtid, int nthr) {
    for (int idx = gtid; idx < M * 128; idx += 2 * nthr) {
        u32x4 r[2], gq[2]; f32x4 s0[2], s1[2];
#pragma unroll
        for (int u = 0; u < 2; ++u) { const int i = idx + u * nthr, t = i >> 7, c8 = i & 127, h = c8 >> 5;
            const f32x4* sp = (const f32x4*)(ssq + ((size_t)t * 4 + h) * 8); s0[u] = sp[0]; s1[u] = sp[1];
            r[u] = *(const u32x4*)(R + (size_t)t * D + 8 * c8); gq[u] = *(const u32x4*)(RG + (size_t)t * D + 8 * c8); }
#pragma unroll
        for (int u = 0; u < 2; ++u) { const int i = idx + u * nthr, t = i >> 7, c8 = i & 127;
            const float tot = ((s0[u][0] + s0[u][1]) + (s0[u][2] + s0[u][3])) + ((s1[u][0] + s1[u][1]) + (s1[u][2] + s1[u][3]));
            const float rstd = 1.0f / sqrtf(tot * (1.0f / 256.0f) + EPS);
            u32x4 w;
            w.x = cvt_pk_bf16(bf_lo(gq[u].x) * (bf_lo(r[u].x) * rstd), bf_hi(gq[u].x) * (bf_hi(r[u].x) * rstd)); w.y = cvt_pk_bf16(bf_lo(gq[u].y) * (bf_lo(r[u].y) * rstd), bf_hi(gq[u].y) * (bf_hi(r[u].y) * rstd));
            w.z = cvt_pk_bf16(bf_lo(gq[u].z) * (bf_lo(r[u].z) * rstd), bf_hi(gq[u].z) * (bf_hi(r[u].z) * rstd)); w.w = cvt_pk_bf16(bf_lo(gq[u].w) * (bf_lo(r[u].w) * rstd), bf_hi(gq[u].w) * (bf_hi(r[u].w) * rstd));
            *(u32x4*)(Ya + (size_t)t * D + 8 * c8) = w; }
    }
}
__device__ __forceinline__ void conv_pass(const bf16* CB, const bf16* Z, const float* cw, bf16* Yb, int gtid, int nthr) {
    const int c8 = gtid & 127;
    const f32x4 w0a = *(const f32x4*)(cw + 8 * c8), w0b = *(const f32x4*)(cw + 8 * c8 + 4), w1a = *(const f32x4*)(cw + D + 8 * c8), w1b = *(const f32x4*)(cw + D + 8 * c8 + 4),
                w2a = *(const f32x4*)(cw + 2 * D + 8 * c8), w2b = *(const f32x4*)(cw + 2 * D + 8 * c8 + 4);
    for (int idx = gtid; idx < M * 128; idx += 2 * nthr) {
        u32x4 z0[2], z1[2], z2[2], cbv[2];
#pragma unroll
        for (int u = 0; u < 2; ++u) { const int t = (idx + u * nthr) >> 7, pos = t & (SEQ - 1);
            z0[u] = *(const u32x4*)(Z + (size_t)t * D + 8 * c8);
            z1[u] = (u32x4){0u, 0u, 0u, 0u}; z2[u] = (u32x4){0u, 0u, 0u, 0u};
            if (pos >= 1) z1[u] = *(const u32x4*)(Z + (size_t)(t - 1) * D + 8 * c8);
            if (pos >= 2) z2[u] = *(const u32x4*)(Z + (size_t)(t - 2) * D + 8 * c8);
            cbv[u] = *(const u32x4*)(CB + (size_t)t * D + 8 * c8); }
#pragma unroll
        for (int u = 0; u < 2; ++u) { const int t = (idx + u * nthr) >> 7;
            float y[8];
            const unsigned zz0[4] = {z0[u].x, z0[u].y, z0[u].z, z0[u].w}, zz1[4] = {z1[u].x, z1[u].y, z1[u].z, z1[u].w}, zz2[4] = {z2[u].x, z2[u].y, z2[u].z, z2[u].w}, cc[4] = {cbv[u].x, cbv[u].y, cbv[u].z, cbv[u].w};
#pragma unroll
            for (int k = 0; k < 4; ++k) {
                const float wa0 = k < 2 ? w0a[2 * k] : w0b[2 * k - 4], wb0 = k < 2 ? w0a[2 * k + 1] : w0b[2 * k - 3];
                const float wa1 = k < 2 ? w1a[2 * k] : w1b[2 * k - 4], wb1 = k < 2 ? w1a[2 * k + 1] : w1b[2 * k - 3];
                const float wa2 = k < 2 ? w2a[2 * k] : w2b[2 * k - 4], wb2 = k < 2 ? w2a[2 * k + 1] : w2b[2 * k - 3];
                y[2 * k] = bf_lo(cc[k]) * (wa0 * bf_lo(zz2[k]) + wa1 * bf_lo(zz1[k]) + wa2 * bf_lo(zz0[k]));
                y[2 * k + 1] = bf_hi(cc[k]) * (wb0 * bf_hi(zz2[k]) + wb1 * bf_hi(zz1[k]) + wb2 * bf_hi(zz0[k]));
            }
            u32x4 w; w.x = cvt_pk_bf16(y[0], y[1]); w.y = cvt_pk_bf16(y[2], y[3]); w.z = cvt_pk_bf16(y[4], y[5]); w.w = cvt_pk_bf16(y[6], y[7]);
            *(u32x4*)(Yb + (size_t)t * D + 8 * c8) = w; }
    }
}

#define RLX_AGENT __ATOMIC_RELAXED, __HIP_MEMORY_SCOPE_AGENT
#define XB_TMO      128
#define XB_XCNT(j)  (256  + 64 * (j))
#define XB_XSUB(j)  (1280 + 64 * (j))
#define XB_XGEN(j)  (2304 + 64 * (j))
#define XB_TOP      3328
#define XB_TOPGEN   3392
#define XCD_BAR_WORDS 3456
#define XB_SPIN_CAP (1u << 18)

__device__ __forceinline__ unsigned xb_ld(unsigned* p)              { return __hip_atomic_load(p, __ATOMIC_RELAXED, __HIP_MEMORY_SCOPE_AGENT); }
__device__ __forceinline__ unsigned xb_add(unsigned* p, unsigned v) { return __hip_atomic_fetch_add(p, v, __ATOMIC_RELAXED, __HIP_MEMORY_SCOPE_AGENT); }
__device__ __forceinline__ unsigned xb_xcc_id() { return (unsigned)__builtin_amdgcn_s_getreg((3 << 11) | 20) & 0xFu; }
#define XB_SPIN(cond, bar) do { unsigned _sp = 0; while (cond) { __builtin_amdgcn_s_sleep(1); \
    if ((++_sp & 255u) == 0u) { if (xb_ld(&(bar)[XB_TMO])) break; if (_sp > XB_SPIN_CAP) { atomicAdd(&(bar)[XB_TMO], 1u); break; } } } } while (0)

struct XcdBarrier {
    unsigned* bar; unsigned x;
    volatile LAS unsigned* st;
};

__device__ __forceinline__ XcdBarrier xcd_barrier_post(unsigned* bar, volatile LAS unsigned* st) {
    XcdBarrier b; b.bar = bar; b.x = xb_xcc_id(); b.st = st;
    if (threadIdx.x == 0) (void)xb_add(&bar[XB_XCNT(b.x)], 1u);
    return b;
}
__device__ __forceinline__ void xcd_barrier_complete(unsigned* bar, unsigned x, unsigned& nloc, unsigned& nx) {
    const unsigned G = gridDim.x * gridDim.y * gridDim.z;
    unsigned sum, cnt, mine, sp = 0u;
    for (;;) {
        sum = 0u; cnt = 0u; mine = 0u;
#pragma unroll
        for (unsigned j = 0; j < 16; ++j) { const unsigned c = xb_ld(&bar[XB_XCNT(j)]); sum += c; cnt += (c > 0u) ? 1u : 0u; mine = (j == x) ? c : mine; }
        if (sum == G) break;
        __builtin_amdgcn_s_sleep(1);
        if ((++sp & 255u) == 0u) { if (xb_ld(&bar[XB_TMO])) break; if (sp > XB_SPIN_CAP) { atomicAdd(&bar[XB_TMO], 1u); break; } }
    }
    nloc = mine > 0u ? mine : 1u; nx = cnt > 0u ? cnt : 1u;
}

__device__ __forceinline__ void xcd_barrier(const XcdBarrier& b) {
    asm volatile("s_waitcnt vmcnt(0)" ::: "memory");
    __syncthreads();
    if (threadIdx.x == 0) {
        unsigned* bar = b.bar;
        __builtin_amdgcn_s_waitcnt(0);
        unsigned nloc = b.st[0], nx = b.st[1];
        if (nloc == 0u) { xcd_barrier_complete(bar, b.x, nloc, nx); b.st[0] = nloc; b.st[1] = nx; }
        const unsigned old = xb_add(&bar[XB_XSUB(b.x)], 1u);
        const unsigned gen = old / nloc;
        if (old + 1u == (gen + 1u) * nloc) {
            __builtin_amdgcn_fence(__ATOMIC_RELEASE, "agent");
            asm volatile("s_waitcnt vmcnt(0)" ::: "memory");
            const unsigned og = xb_add(&bar[XB_TOP], 1u);
            const unsigned tg = og / nx;
            if (og + 1u == (tg + 1u) * nx) xb_add(&bar[XB_TOPGEN], 1u);
            else XB_SPIN(xb_ld(&bar[XB_TOPGEN]) == tg, bar);
            __builtin_amdgcn_fence(__ATOMIC_ACQUIRE, "agent");
            xb_add(&bar[XB_XGEN(b.x)], 1u);
            asm volatile("s_waitcnt vmcnt(0)" ::: "memory");
        } else {
            XB_SPIN(xb_ld(&bar[XB_XGEN(b.x)]) == gen, bar);
            __builtin_amdgcn_fence(__ATOMIC_ACQUIRE, "agent");
            asm volatile("s_waitcnt vmcnt(0)" ::: "memory");
        }
    }
    __syncthreads();
}

struct Args { const float* in[21]; float* out; unsigned char* ws; int ph_lo, ph_hi, dump_mib, pad; };

__global__ void __launch_bounds__(512) hybrid_fwd(Args a) {
    extern __shared__ __attribute__((aligned(16))) unsigned char lds_raw[];
    LAS unsigned char* lds = (LAS unsigned char*)lds_raw;
#if MK_ONE_LAUNCH
    if (threadIdx.x < 2) ((volatile LAS unsigned*)(lds + MISC_OFF))[threadIdx.x] = 0u;
    __syncthreads();
    const XcdBarrier xbar = xcd_barrier_post((unsigned*)a.ws + CW_BAR, (volatile LAS unsigned*)(lds + MISC_OFF));
#endif
    for (int ph = a.ph_lo; ph < a.ph_hi; ++ph) {
        int tid = threadIdx.x; asm volatile("" : "+v"(tid));
        int G = gridDim.x, bx = blockIdx.x; asm volatile("" : "+s"(G), "+s"(bx));
        const int vcu = (G % 8 == 0) ? (bx % 8) * (G / 8) + bx / 8 : bx;
        const int lane = tid & 63, wave = __builtin_amdgcn_readfirstlane(tid >> 6);
        const int gw = vcu * 8 + wave, ngw = G * 8, gtid = vcu * 512 + tid, nthr = G * 512;
        const __attribute__((address_space(4))) Args* ap = (const __attribute__((address_space(4))) Args*)__builtin_amdgcn_kernarg_segment_ptr(); asm volatile("" : "+s"(ap));
        unsigned char* ws = ap->ws;
        bf16* H = (bf16*)ap->out;
        float* HF = (float*)(ws + WS_BIG + 176 * MiB);
        const float* mod = (const float*)(ws + WS_MOD);
        LAS float* scr = (LAS float*)(lds + wave * 8448);
        bf16* U = (bf16*)(ws + WS_U);
        unsigned char* big = ws + WS_BIG;
        bf16* Yb = (bf16*)(ws + WS_Y); bf16* Yc = (bf16*)(ws + WS_Y + PLANE); bf16* Ya = (bf16*)(ws + WS_Y + 2 * PLANE);
#if MK_ONE_LAUNCH
        if (ph > a.ph_lo) { if (ph == a.ph_lo + 1) cg::this_grid().sync(); else xcd_barrier(xbar); }
#endif
        if (ph == 100) {
            const bf16* src = (const bf16*)(ap->ws + (size_t)ap->dump_mib * MiB); float* o = ap->out;
            for (int i = vcu * 512 + tid; i < M * D; i += G * 512) o[i] = __uint_as_float(((unsigned)src[i]) << 16);
            continue; }
        if (ph == 0) { p0_phase(lds, ap->in[1], ap->in[2], ap->in[3], ws, vcu, G, tid, lane, wave); continue; }
        if (ph == NPHASE - 1) { final_norm_rows(HF, ap->out, ap->in[20], gw, ngw, lane); continue; }
#ifndef MK_DUP_NOP
#define MK_DUP_NOP 0
#endif
#ifdef MK_DUP_K
        const int l = (ph - 1) / 15, slot_ = (ph - 1) % 15, k = slot_ <= MK_DUP_K ? slot_ : slot_ - 1;
        const bool dupnop = (slot_ == MK_DUP_K + 1) && MK_DUP_NOP;
#else
        const int l = (ph - 1) / 14, k = (ph - 1) % 14;
        const bool dupnop = false;
#endif
        const float* modl = mod + (size_t)l * 8 * MODW;
        if (k == 1 || k == 12) {
            const pg8::Gemm g{U, (const bf16*)(ws + W_W13), M, 2 * DFF, D, D, 30, 0}; const pg8::EpiUp eu{(bf16*)big, dupnop};
            pg8::StaticOrder S; S.init(M, 2 * DFF, G, bx); pg8::gemm_phase<pg8::EpiUp>(lds, g, S, eu, tid);
        } else if (k == 2 || k == 13 || k == 10) {
            const bool wo = (k == 10); const int KK = wo ? D : DFF;
            const pg8::Gemm g{wo ? (const bf16*)U : (const bf16*)big, (const bf16*)(ws + (wo ? W_OUT : W_W2)), M, D, KK, KK, 30, 0};
            const bool first = (l == 0 && k == 2), lastres = (l == 1 && k == 13);
            const pg8::EpiRes er{first ? (const void*)ap->in[0] : (const void*)H, lastres ? (void*)HF : (void*)H, modl + (k == 2 ? 2 : (wo ? 5 : 8)) * D, wo ? 1.0f : 0.5f, first ? 0 : 1, lastres ? 0 : 1};
            pg8::StaticOrder S; S.init(M, D, G, bx); pg8::gemm_phase<pg8::EpiRes>(lds, g, S, er, tid);
        } else if (k == 4 || k == 6 || k == 8) {
            const int grp = k == 4 ? 0 : (k == 6 ? 1 : 2), roff = grp == 0 ? 0 : (grp == 1 ? 4096 : 8448), NN = grp == 0 ? 4096 : (grp == 1 ? 4352 : 3072);
            if (k == 6) { if (G == 256) { if (bx >= 128) ya_pass(Ya, (const bf16*)(big + 208 * MiB), (const float*)(ws + WS_SSQ), Ya, (bx - 128) * 512 + tid, 128 * 512); }
                          else ya_pass(Ya, (const bf16*)(big + 208 * MiB), (const float*)(ws + WS_SSQ), Ya, gtid, nthr); }
            const pg8::Gemm g{U, (const bf16*)(ws + W_IN) + (size_t)roff * D, M, NN, D, D, 30, 0}; const pg8::EpiProj ep{big, grp, (const float*)(ws + WS_ROT)};
            pg8::StaticOrder S; S.init(M, NN, G, bx); pg8::gemm_phase<pg8::EpiProj>(lds, g, S, ep, tid);
        } else if (k == 9) {
            const pg8::Gemm g{Yb, (const bf16*)(ws + W_PCAT), M, D, 3 * D, D, 4, PLANE}; const pg8::EpiMerge em{(const bf16*)big, U};
            pg8::StaticOrder S; S.init(M, D, G, bx); pg8::gemm_phase<pg8::EpiMerge>(lds, g, S, em, tid);
        } else if (k == 0) {
            norm_rows(l == 0 ? (const void*)ap->in[0] : (const void*)H, l == 0 ? 0 : 1, ap->in[4] + (size_t)l * D, modl + 0 * D, modl + 1 * D, U, gw, ngw, lane);
            convert_ffn(ap->in[5] + (size_t)l * D * DFF, ap->in[6] + (size_t)l * D * DFF, ap->in[7] + (size_t)l * D * DFF, ws, scr, gw, ngw, lane);
        } else if (k == 3) {
            norm_rows(H, 1, ap->in[8] + (size_t)l * D, modl + 3 * D, modl + 4 * D, U, gw, ngw, lane);
            convert_mixer(ap->in[9] + (size_t)l * D * INC, ap->in[12] + (size_t)l * D * D, ap->in[13] + (size_t)l * D * D, ap->in[14] + (size_t)l * D * D, ap->in[15] + (size_t)l * D * D, ws, scr, gw, ngw, lane);
        } else if (k == 11) {
            norm_rows(H, 1, ap->in[16] + (size_t)l * D, modl + 6 * D, modl + 7 * D, U, gw, ngw, lane);
            convert_ffn(ap->in[17] + (size_t)l * D * DFF, ap->in[18] + (size_t)l * D * DFF, ap->in[19] + (size_t)l * D * DFF, ws, scr, gw, ngw, lane);
        } else if (k == 5) {
#ifdef MK_SCAN_PMODE
            if (dupnop) scan_phase(lds, (const bf16*)big, (const bf16*)(big + PLANE), (const bf16*)(big + 2 * PLANE), Yc, (float*)(ws + WS_SSQ), vcu, tid, lane, wave, MK_SCAN_PMODE);
            else
#endif
            scan_phase(lds, (const bf16*)big, (const bf16*)(big + PLANE), (const bf16*)(big + 2 * PLANE), Ya, (float*)(ws + WS_SSQ), vcu, tid, lane, wave);
        } else if (k == 7) {
            const bool fuse = (G == 256);
            swa_phase(lds, (const bf16*)(big + 2 * PLANE), (const bf16*)(big + 3 * PLANE), Yc, ap->in[11] + (size_t)l * 16, vcu, G, tid, lane, wave,
                      fuse, (const bf16*)big, (const bf16*)(big + PLANE), ap->in[10] + (size_t)l * 3 * D, Yb, gtid, nthr);
            if (!fuse) conv_pass((const bf16*)big, (const bf16*)(big + PLANE), ap->in[10] + (size_t)l * 3 * D, Yb, gtid, nthr);
        }
    }
}

extern "C" void kernel_launch(void* const* d_in, const int* in_sizes, int n_in, void* d_out, int out_size, void* d_ws, size_t ws_size, hipStream_t stream) {
    static int grid = 0;
    if (grid == 0) {
        if (n_in != 21 || in_sizes[0] != M * D || out_size != M * D || ws_size < WS_END) { fprintf(stderr, "kernel_launch: unexpected shapes / workspace (n_in %d, in0 %d, out %d, ws %zu < %zu)\n", n_in, n_in > 0 ? in_sizes[0] : -1, out_size, ws_size, (size_t)WS_END); grid = -1; return; }
        if (hipFuncSetAttribute((const void*)hybrid_fwd, hipFuncAttributeMaxDynamicSharedMemorySize, LDS_BYTES) != hipSuccess) { fprintf(stderr, "kernel_launch: hipFuncSetAttribute failed\n"); grid = -1; return; }
        int dev = 0, cus = 0, per_cu = 0;
        (void)hipGetDevice(&dev); (void)hipDeviceGetAttribute(&cus, hipDeviceAttributeMultiprocessorCount, dev);
        (void)hipOccupancyMaxActiveBlocksPerMultiprocessor(&per_cu, (const void*)hybrid_fwd, 512, LDS_BYTES);
        (void)hipGetLastError();
        if (per_cu < 1) { fprintf(stderr, "kernel_launch: occupancy query says %d blocks per CU\n", per_cu); per_cu = 1; }
        grid = cus * 1;
        if (grid != 256) fprintf(stderr, "kernel_launch: note: %d CUs\n", grid);
    }
    if (grid < 0) return;
    Args a{};
    for (int i = 0; i < 21; ++i) a.in[i] = (const float*)d_in[i];
    a.out = (float*)d_out; a.ws = (unsigned char*)d_ws;
#if MK_ONE_LAUNCH
    if (hipMemsetAsync(d_ws, 0, CTL_ZERO_BYTES, stream) != hipSuccess) { fprintf(stderr, "kernel_launch: hipMemsetAsync failed\n"); return; }
    a.ph_lo = 0; a.ph_hi = NPHASE;
    void* args[] = {&a};
    hipError_t e = hipLaunchCooperativeKernel((const void*)hybrid_fwd, dim3(grid), dim3(512), args, LDS_BYTES, stream);
    if (e != hipSuccess) fprintf(stderr, "kernel_launch: cooperative launch failed: %s (grid %d)\n", hipGetErrorString(e), grid);
#else
#ifndef MK_CUT
#define MK_CUT NPHASE
#endif
    for (int ph = 0; ph < MK_CUT; ++ph) { a.ph_lo = ph; a.ph_hi = ph + 1; hipLaunchKernelGGL(hybrid_fwd, dim3(grid), dim3(512), LDS_BYTES, stream, a); }
#ifdef MK_DUMP
    a.ph_lo = 100; a.ph_hi = 101; a.dump_mib = MK_DUMP; hipLaunchKernelGGL(hybrid_fwd, dim3(grid), dim3(512), LDS_BYTES, stream, a);
#endif
#endif
}
```

```cpp
#include <hip/hip_runtime.h>
#include <hip/hip_cooperative_groups.h>
#include <cstdio>
#include <cstdint>
namespace cg = cooperative_groups;

#ifndef MK_ONE_LAUNCH
#define MK_ONE_LAUNCH 1
#endif

#define LAS __attribute__((address_space(3)))
typedef unsigned short bf16;
typedef short bf16x8 __attribute__((ext_vector_type(8)));
typedef short s16x4 __attribute__((ext_vector_type(4)));
typedef float f32x4 __attribute__((ext_vector_type(4)));
typedef float f32x2 __attribute__((ext_vector_type(2)));
typedef unsigned u32x4 __attribute__((ext_vector_type(4)));
typedef unsigned u32x2 __attribute__((ext_vector_type(2)));

constexpr int D = 1024, BATCH = 8, SEQ = 4096, M = BATCH * SEQ, DFF = 2816, INC = 11520, MODW = 9 * D;
constexpr float EPS = 1e-6f;
constexpr float LOG2E = 1.4426950408889634f;
constexpr size_t MiB = 1u << 20;
constexpr size_t WS_MOD = 1 * MiB;
constexpr size_t WS_ROT = 2 * MiB;
constexpr size_t WS_SSQ = 6 * MiB;
constexpr size_t WS_W = 10 * MiB;
constexpr size_t W_W13 = WS_W, W_W2 = WS_W + 11 * MiB;
constexpr size_t W_IN = WS_W, W_PCAT = WS_W + 23 * MiB, W_OUT = WS_W + 29 * MiB;
constexpr size_t WS_U = 42 * MiB;
constexpr size_t WS_BIG = 106 * MiB;
constexpr size_t PLANE = 64 * MiB;
constexpr size_t WS_Y = WS_BIG + 208 * MiB;
constexpr size_t WS_END = WS_Y + 3 * PLANE;
constexpr int LDS_BYTES = 147456;
#ifdef MK_DUP_K
constexpr int NPHASE = 32;
#else
constexpr int NPHASE = 30;
#endif
constexpr int CW_BAR = 4096;
constexpr size_t CTL_ZERO_BYTES = 65536;
constexpr int MISC_OFF = 131072 + 64;

typedef __bf16 bf16x2_t __attribute__((ext_vector_type(2)));
__device__ __forceinline__ unsigned cvt_pk_bf16(float lo, float hi) { const f32x2 v = {lo, hi}; const bf16x2_t b = __builtin_convertvector(v, bf16x2_t); return __builtin_bit_cast(unsigned, b); }
__device__ __forceinline__ float bf_lo(unsigned w) { return __uint_as_float(w << 16); }
__device__ __forceinline__ float bf_hi(unsigned w) { return __uint_as_float(w & 0xffff0000u); }
__device__ __forceinline__ float silu_f(float x) { return x * __builtin_amdgcn_rcpf(1.0f + __builtin_amdgcn_exp2f(-LOG2E * x)); }
__device__ __forceinline__ float sigmoid_f(float x) { return __builtin_amdgcn_rcpf(1.0f + __builtin_amdgcn_exp2f(-LOG2E * x)); }
__device__ __forceinline__ f32x4 mfma16(bf16x8 a, bf16x8 b, f32x4 c) { return __builtin_amdgcn_mfma_f32_16x16x32_bf16(a, b, c, 0, 0, 0); }
typedef short v4i16_t __attribute__((ext_vector_type(4)));
__device__ __forceinline__ s16x4 tr_read(LAS const unsigned char* p) { return __builtin_bit_cast(s16x4, __builtin_amdgcn_ds_read_tr16_b64_v4i16((LAS v4i16_t*)p)); }
__device__ __forceinline__ bf16x8 cat4(s16x4 lo, s16x4 hi) { return (bf16x8){lo[0], lo[1], lo[2], lo[3], hi[0], hi[1], hi[2], hi[3]}; }
#define LDS_WAIT() asm volatile("s_waitcnt lgkmcnt(0)" ::: "memory")
#define WG_BAR() do { asm volatile("s_waitcnt lgkmcnt(0)" ::: "memory"); __builtin_amdgcn_s_barrier(); asm volatile("" ::: "memory"); } while (0)
__device__ __forceinline__ float wave_sum(float v) {
#pragma unroll
    for (int o = 1; o < 64; o <<= 1) v += __shfl_xor(v, o);
    return v;
}

namespace pg8 {
constexpr int BM = 256, BK = 64, HALF = 128, HTB = HALF * BK * 2, STAGE_BYTES = 8 * HTB, NXCD = 8, WGM = 8;
__host__ __device__ __forceinline__ int lds_byte(int r, int c) { const int st = (r >> 4) * 2 + (c >> 5), rr = r & 15, cc = c & 31, ob = rr * 64 + cc * 2; return st * 1024 + (ob ^ (((ob >> 9) & 1) << 5)); }
__host__ __device__ __forceinline__ void stage_rc(int b, int& R, int& C) { const int st = b / 1024, sb = b % 1024, swz = sb ^ (((sb >> 9) & 1) << 5); R = (st >> 1) * 16 + swz / 64; C = (st & 1) * 32 + (swz % 64) / 2; }
__host__ __device__ __forceinline__ int perm32(int rho) { const int n = rho >> 4, i = rho & 15; return 8 * (i >> 2) + 4 * n + (i & 3); }

struct Unit { int pm, pn; };
struct Gemm { const bf16* A; const bf16* Bt; int M, N, K, lda, segShift; size_t segStride; };

struct StaticOrder {
    int nM, nN, nwg, G, c;
    __device__ void init(int M_, int N_, int G_, int c_) { nM = M_ / BM; nN = N_ / BM; nwg = nM * nN; G = G_; c = c_; }
    __device__ bool next(int i, Unit& u) const {
        const long L = (long)i * G + c; if (L >= nwg) return false;
        int wgid = (int)L; { const int q = nwg / NXCD, r = nwg % NXCD, xcd = wgid % NXCD, off = wgid / NXCD; wgid = (xcd < r ? xcd * (q + 1) : r * (q + 1) + (xcd - r) * q) + off; }
        const int nig = WGM * nN, gid = wgid / nig, fm = gid * WGM, gsz = (nM - fm) < WGM ? (nM - fm) : WGM;
        u.pm = fm + ((wgid % nig) % gsz); u.pn = (wgid % nig) / gsz; return true;
    }
};

typedef f32x4 Acc[2][2][4][2];

struct EpiUp {
    static constexpr bool PERM = true, HAS_MID = false;
    bf16* O; bool nop;
    __device__ __forceinline__ void mid(Acc&, const Unit&, int, int, int, int, int) const {}
    __device__ __forceinline__ void operator()(const Acc& acc, const Unit& u, int wr, int wc, int fr, int fq) const {
        if (nop) return;
        const int row0 = u.pm * BM + wr * 64 + fr, col0 = u.pn * 128 + wc * 32 + 8 * fq;
#pragma unroll
        for (int ai = 0; ai < 2; ++ai)
#pragma unroll
            for (int m = 0; m < 4; ++m) {
                bf16* rowp = O + (size_t)(row0 + ai * HALF + m * 16) * DFF + col0;
                const f32x4 a0 = acc[ai][0][m][0], a1 = acc[ai][0][m][1], b0 = acc[ai][1][m][0], b1 = acc[ai][1][m][1];
                u32x4 w;
                w.x = cvt_pk_bf16(silu_f(a0[0]) * b0[0], silu_f(a0[1]) * b0[1]); w.y = cvt_pk_bf16(silu_f(a0[2]) * b0[2], silu_f(a0[3]) * b0[3]);
                w.z = cvt_pk_bf16(silu_f(a1[0]) * b1[0], silu_f(a1[1]) * b1[1]); w.w = cvt_pk_bf16(silu_f(a1[2]) * b1[2], silu_f(a1[3]) * b1[3]);
                *(u32x4*)rowp = w;
            }
    }
};
struct EpiRes {
    static constexpr bool PERM = false, HAS_MID = false;
    const void* Hin; void* Hout; const float* gate; float coef; int in_bf16, out_bf16;
    __device__ __forceinline__ void mid(Acc&, const Unit&, int, int, int, int, int) const {}
    __device__ __forceinline__ void operator()(const Acc& acc, const Unit& u, int wr, int wc, int fr, int fq) const {
        const int row0 = u.pm * BM + wr * 64 + fr, col0 = u.pn * BM + wc * 32 + 4 * fq, b = u.pm >> 4;
        f32x4 gv[2][2];
#pragma unroll
        for (int bj = 0; bj < 2; ++bj)
#pragma unroll
            for (int n = 0; n < 2; ++n) gv[bj][n] = *(const f32x4*)(gate + (size_t)b * MODW + col0 + bj * HALF + n * 16) * coef;
#pragma unroll
        for (int ah = 0; ah < 4; ++ah) { const int ai = ah >> 1, m0 = (ah & 1) * 2;
            f32x4 h[2][2][2];
            if (in_bf16) {
                u32x2 hb[2][2][2];
#pragma unroll
                for (int mm = 0; mm < 2; ++mm) { const size_t off = (size_t)(row0 + ai * HALF + (m0 + mm) * 16) * D + col0;
#pragma unroll
                    for (int bj = 0; bj < 2; ++bj)
#pragma unroll
                        for (int n = 0; n < 2; ++n) hb[mm][bj][n] = *(const u32x2*)((const bf16*)Hin + off + bj * HALF + n * 16); }
                asm volatile("" ::: "memory");
#pragma unroll
                for (int mm = 0; mm < 2; ++mm)
#pragma unroll
                    for (int bj = 0; bj < 2; ++bj)
#pragma unroll
                        for (int n = 0; n < 2; ++n) h[mm][bj][n] = (f32x4){bf_lo(hb[mm][bj][n].x), bf_hi(hb[mm][bj][n].x), bf_lo(hb[mm][bj][n].y), bf_hi(hb[mm][bj][n].y)};
            } else {
#pragma unroll
                for (int mm = 0; mm < 2; ++mm) { const size_t off = (size_t)(row0 + ai * HALF + (m0 + mm) * 16) * D + col0;
#pragma unroll
                    for (int bj = 0; bj < 2; ++bj)
#pragma unroll
                        for (int n = 0; n < 2; ++n) h[mm][bj][n] = *(const f32x4*)((const float*)Hin + off + bj * HALF + n * 16); }
                asm volatile("" ::: "memory");
            }
#pragma unroll
            for (int mm = 0; mm < 2; ++mm) { const size_t off = (size_t)(row0 + ai * HALF + (m0 + mm) * 16) * D + col0;
#pragma unroll
                for (int bj = 0; bj < 2; ++bj)
#pragma unroll
                    for (int n = 0; n < 2; ++n) { const f32x4 o = h[mm][bj][n] + gv[bj][n] * acc[ai][bj][m0 + mm][n];
                        if (out_bf16) { u32x2 w; w.x = cvt_pk_bf16(o[0], o[1]); w.y = cvt_pk_bf16(o[2], o[3]); *(u32x2*)((bf16*)Hout + off + bj * HALF + n * 16) = w; }
                        else *(f32x4*)((float*)Hout + off + bj * HALF + n * 16) = o; } }
            asm volatile("" ::: "memory");
        }
    }
};
struct EpiProj {
    static constexpr bool PERM = true, HAS_MID = false;
    unsigned char* big; int grp; const float* rot;
    __device__ __forceinline__ void mid(Acc&, const Unit&, int, int, int, int, int) const {}
    __device__ __forceinline__ void operator()(const Acc& acc, const Unit& u, int wr, int wc, int fr, int fq) const {
        int mode, plane, colt, ldc = D; float sc = 1.f; const int pn = u.pn;
        if (grp == 0) { plane = pn >> 2; colt = (pn & 3) * 256; mode = plane < 2 ? 1 : (plane == 2 ? 0 : 2); sc = plane == 1 ? 0.0625f : 1.f; }
        else if (grp == 1) {
            if (pn < 4) { plane = 0; colt = 256 * pn; mode = 0; }
            else if (pn < 12) { plane = 1; colt = 128 * (pn - 4); mode = 4; }
            else if (pn < 16) { plane = 2; colt = 256 * (pn - 12); mode = 0; sc = 0.125f; }
            else { plane = 3; colt = 0; mode = 0; ldc = 256; }
        } else { plane = pn >> 2; colt = (pn & 3) * 256; mode = 3; }
        bf16* O = (grp == 0 && plane == 3) ? (bf16*)(big + 208 * MiB) : (bf16*)(big + (size_t)plane * PLANE);
        const int row0 = u.pm * BM + wr * 64 + fr, cl = wc * 32 + 8 * fq;
        if (mode == 4) {
#pragma unroll
            for (int ai = 0; ai < 2; ++ai)
#pragma unroll
                for (int m = 0; m < 4; ++m) {
                    const f32x4 v0 = acc[ai][0][m][0] * acc[ai][1][m][0], v1 = acc[ai][0][m][1] * acc[ai][1][m][1];
                    u32x4 w; w.x = cvt_pk_bf16(v0[0], v0[1]); w.y = cvt_pk_bf16(v0[2], v0[3]); w.z = cvt_pk_bf16(v1[0], v1[1]); w.w = cvt_pk_bf16(v1[2], v1[3]);
                    *(u32x4*)(O + (size_t)(row0 + ai * HALF + m * 16) * D + colt + cl) = w;
                }
        } else if (mode == 1) {
#pragma unroll
            for (int ai = 0; ai < 2; ++ai) {
                f32x4 cs[4][4];
#pragma unroll
                for (int m = 0; m < 4; ++m) { const int pos = (row0 + ai * HALF + m * 16) & (SEQ - 1); const f32x4* rp = (const f32x4*)(rot + ((size_t)pos * 128 + cl) * 2);
#pragma unroll
                    for (int q = 0; q < 4; ++q) cs[m][q] = rp[q]; }
                asm volatile("" ::: "memory");
#pragma unroll
                for (int m = 0; m < 4; ++m) {
                    const int row = row0 + ai * HALF + m * 16;
                    const f32x4 c0 = cs[m][0], c1 = cs[m][1], c2 = cs[m][2], c3 = cs[m][3];
                    const f32x4 t1a = acc[ai][0][m][0], t1b = acc[ai][0][m][1], t2a = acc[ai][1][m][0], t2b = acc[ai][1][m][1];
                    u32x4 w1, w2;
                    w1.x = cvt_pk_bf16((t1a[0] * c0[0] - t2a[0] * c0[1]) * sc, (t1a[1] * c0[2] - t2a[1] * c0[3]) * sc);
                    w1.y = cvt_pk_bf16((t1a[2] * c1[0] - t2a[2] * c1[1]) * sc, (t1a[3] * c1[2] - t2a[3] * c1[3]) * sc);
                    w1.z = cvt_pk_bf16((t1b[0] * c2[0] - t2b[0] * c2[1]) * sc, (t1b[1] * c2[2] - t2b[1] * c2[3]) * sc);
                    w1.w = cvt_pk_bf16((t1b[2] * c3[0] - t2b[2] * c3[1]) * sc, (t1b[3] * c3[2] - t2b[3] * c3[3]) * sc);
                    w2.x = cvt_pk_bf16((t2a[0] * c0[0] + t1a[0] * c0[1]) * sc, (t2a[1] * c0[2] + t1a[1] * c0[3]) * sc);
                    w2.y = cvt_pk_bf16((t2a[2] * c1[0] + t1a[2] * c1[1]) * sc, (t2a[3] * c1[2] + t1a[3] * c1[3]) * sc);
                    w2.z = cvt_pk_bf16((t2b[0] * c2[0] + t1b[0] * c2[1]) * sc, (t2b[1] * c2[2] + t1b[1] * c2[3]) * sc);
                    w2.w = cvt_pk_bf16((t2b[2] * c3[0] + t1b[2] * c3[1]) * sc, (t2b[3] * c3[2] + t1b[3] * c3[3]) * sc);
                    bf16* rowp = O + (size_t)row * D + colt + cl;
                    *(u32x4*)rowp = w1; *(u32x4*)(rowp + HALF) = w2;
                }
                asm volatile("" ::: "memory");
            }
        } else {
#pragma unroll
            for (int ai = 0; ai < 2; ++ai)
#pragma unroll
                for (int m = 0; m < 4; ++m) {
                    bf16* rowp = O + (size_t)(row0 + ai * HALF + m * 16) * ldc + colt + cl;
#pragma unroll
                    for (int bj = 0; bj < 2; ++bj) {
                        f32x4 v0 = acc[ai][bj][m][0], v1 = acc[ai][bj][m][1];
                        if (mode == 0) { v0 = v0 * sc; v1 = v1 * sc; }
                        else if (mode == 2) {
#pragma unroll
                            for (int j = 0; j < 4; ++j) { v0[j] = silu_f(v0[j]); v1[j] = silu_f(v1[j]); } }
                        else {
#pragma unroll
                            for (int j = 0; j < 4; ++j) { v0[j] = sigmoid_f(v0[j]); v1[j] = sigmoid_f(v1[j]); } }
                        u32x4 w; w.x = cvt_pk_bf16(v0[0], v0[1]); w.y = cvt_pk_bf16(v0[2], v0[3]); w.z = cvt_pk_bf16(v1[0], v1[1]); w.w = cvt_pk_bf16(v1[2], v1[3]);
                        *(u32x4*)(rowp + bj * HALF) = w;
                    }
                }
        }
    }
};
struct EpiMerge {
    static constexpr bool PERM = true, HAS_MID = true;
    const bf16* gates;
    bf16* O;
    __device__ __forceinline__ void ld8(int plane, size_t off, f32x4& lo, f32x4& hi) const {
        const u32x4 w = *(const u32x4*)(gates + (size_t)plane * (PLANE / 2) + off);
        lo = (f32x4){bf_lo(w.x), bf_hi(w.x), bf_lo(w.y), bf_hi(w.y)}; hi = (f32x4){bf_lo(w.z), bf_hi(w.z), bf_lo(w.w), bf_hi(w.w)};
    }
    __device__ __forceinline__ u32x4 ldg(int plane, size_t off) const { return *(const u32x4*)(gates + (size_t)plane * (PLANE / 2) + off); }
    static __device__ __forceinline__ void unpack(const u32x4 w, f32x4& lo, f32x4& hi) {
        lo = (f32x4){bf_lo(w.x), bf_hi(w.x), bf_lo(w.y), bf_hi(w.y)}; hi = (f32x4){bf_lo(w.z), bf_hi(w.z), bf_lo(w.w), bf_hi(w.w)}; }
    __device__ __forceinline__ void mid(Acc& acc, const Unit& u, int which, int wr, int wc, int fr, int fq) const {
        const int pnum = which == 1 ? 1 : 2, pden = which == 1 ? 2 : 0;
        const int row0 = u.pm * BM + wr * 64 + fr, col0 = u.pn * BM + wc * 32 + 8 * fq;
#pragma unroll
        for (int ai = 0; ai < 2; ++ai) {
            u32x4 wn[4][2], wd[4][2];
#pragma unroll
            for (int m = 0; m < 4; ++m) { const size_t off = (size_t)(row0 + ai * HALF + m * 16) * D + col0;
#pragma unroll
                for (int bj = 0; bj < 2; ++bj) { wn[m][bj] = ldg(pnum, off + bj * HALF); wd[m][bj] = ldg(pden, off + bj * HALF); } }
            asm volatile("" ::: "memory");
#pragma unroll
            for (int m = 0; m < 4; ++m)
#pragma unroll
                for (int bj = 0; bj < 2; ++bj) {
                    f32x4 nl, nh, dl, dh; unpack(wn[m][bj], nl, nh); unpack(wd[m][bj], dl, dh);
#pragma unroll
                    for (int j = 0; j < 4; ++j) { acc[ai][bj][m][0][j] *= nl[j] * __builtin_amdgcn_rcpf(dl[j]); acc[ai][bj][m][1][j] *= nh[j] * __builtin_amdgcn_rcpf(dh[j]); }
                }
            asm volatile("" ::: "memory");
        }
    }
    __device__ __forceinline__ void operator()(const Acc& acc, const Unit& u, int wr, int wc, int fr, int fq) const {
        const int row0 = u.pm * BM + wr * 64 + fr, col0 = u.pn * BM + wc * 32 + 8 * fq;
#pragma unroll
        for (int ai = 0; ai < 2; ++ai) {
            u32x4 wg[4][2];
#pragma unroll
            for (int m = 0; m < 4; ++m) { const size_t off = (size_t)(row0 + ai * HALF + m * 16) * D + col0;
#pragma unroll
                for (int bj = 0; bj < 2; ++bj) wg[m][bj] = ldg(0, off + bj * HALF); }
            asm volatile("" ::: "memory");
#pragma unroll
            for (int m = 0; m < 4; ++m) { const size_t off = (size_t)(row0 + ai * HALF + m * 16) * D + col0;
#pragma unroll
                for (int bj = 0; bj < 2; ++bj) {
                    f32x4 gl, gh; unpack(wg[m][bj], gl, gh);
                    const f32x4 v0 = acc[ai][bj][m][0] * gl, v1 = acc[ai][bj][m][1] * gh;
                    u32x4 w; w.x = cvt_pk_bf16(v0[0], v0[1]); w.y = cvt_pk_bf16(v0[2], v0[3]); w.z = cvt_pk_bf16(v1[0], v1[1]); w.w = cvt_pk_bf16(v1[2], v1[3]);
                    *(u32x4*)(O + off + bj * HALF) = w;
                } }
            asm volatile("" ::: "memory");
        }
    }
};

template <class Epi>
__device__ __forceinline__ void gemm_phase(LAS unsigned char* lds, const Gemm g, const StaticOrder& S, const Epi& E, const int tid) {
    const int wid = __builtin_amdgcn_readfirstlane(tid >> 6), lane = tid & 63, wr = wid >> 2, wc = wid & 3, fr = lane & 15, fq = lane >> 4;
    const int K = g.K, nt = K / BK, lda = g.lda, segMask = (1 << g.segShift) - 1;
    unsigned voffA[2], voffB[2];
#pragma unroll
    for (int i = 0; i < 2; ++i) { int R, C; stage_rc(tid * 16 + i * 8192, R, C); const int Rb = Epi::PERM ? ((R & ~31) + perm32(R & 31)) : R;
        voffA[i] = (unsigned)(R * lda + C) * 2u; voffB[i] = (unsigned)(Rb * K + C) * 2u; }
    const size_t kstep = (size_t)(BK * 2);
    const size_t hstepA = (size_t)HALF * lda * 2, tstepA = 2 * hstepA;
    const size_t hstepB = (size_t)HALF * K * 2, tstepB = 2 * hstepB;
    const unsigned ldsw = (unsigned)wid * 1024u;
    const int aoff = lds_byte(wr * 64 + fr, fq * 8), boff = lds_byte(wc * 32 + fr, fq * 8);
#define PG8_KOFFA(t) ((size_t)((t) >> g.segShift) * g.segStride + (size_t)((t) & segMask) * kstep)
#define PG8_SA(b, h) (((b) * 2 + (h)) * HTB)
#define PG8_SB(b, h) ((4 + (b) * 2 + (h)) * HTB)
#define PG8_STAGE(bufoff, gbase, voff) do { _Pragma("unroll") for (int _i = 0; _i < 2; ++_i) \
        __builtin_amdgcn_global_load_lds((const unsigned*)((const char*)(gbase) + (voff)[_i]), (LAS unsigned*)(lds + (bufoff) + ldsw + _i * 8192), 16, 0, 0); } while (0)
#define PG8_LDA(dst, b, h) do { _Pragma("unroll") for (int m = 0; m < 4; ++m) _Pragma("unroll") for (int k = 0; k < 2; ++k) dst[m][k] = *(const LAS bf16x8*)(lds + PG8_SA(b, h) + aoff + m * 2048 + k * 1024); } while (0)
#define PG8_LDB(dst, b, h) do { _Pragma("unroll") for (int n = 0; n < 2; ++n) _Pragma("unroll") for (int k = 0; k < 2; ++k) dst[n][k] = *(const LAS bf16x8*)(lds + PG8_SB(b, h) + boff + n * 2048 + k * 1024); } while (0)
#define PG8_MMA(ai, bj, At, Bt) do { __builtin_amdgcn_s_setprio(1); _Pragma("unroll") for (int m = 0; m < 4; ++m) _Pragma("unroll") for (int n = 0; n < 2; ++n) _Pragma("unroll") for (int k = 0; k < 2; ++k) \
        acc[ai][bj][m][n] = __builtin_amdgcn_mfma_f32_16x16x32_bf16(Bt[n][k], At[m][k], acc[ai][bj][m][n], 0, 0, 0); __builtin_amdgcn_s_setprio(0); } while (0)
#define PG8_WAIT_V(n) asm volatile("s_waitcnt vmcnt(" #n ")" ::: "memory")
#define PG8_WAIT_L(n) asm volatile("s_waitcnt lgkmcnt(" #n ")" ::: "memory")
#define PG8_BAR __builtin_amdgcn_s_barrier()
#define PG8_SCHED __builtin_amdgcn_sched_barrier(0)
    Unit cur, nxt; int ui = 0;
    if (!S.next(0, cur)) return;
    Acc acc;
#pragma unroll
    for (int a = 0; a < 2; ++a)
#pragma unroll
        for (int b = 0; b < 2; ++b)
#pragma unroll
            for (int m = 0; m < 4; ++m)
#pragma unroll
                for (int n = 0; n < 2; ++n) acc[a][b][m][n] = (f32x4){0.f, 0.f, 0.f, 0.f};
    bf16x8 At[4][2], B0[2][2], B1[2][2];
    const char* cA = (const char*)g.A + (size_t)cur.pm * tstepA; const char* cB = (const char*)g.Bt + (size_t)cur.pn * tstepB;
    PG8_STAGE(PG8_SB(0, 0), cB, voffB); PG8_STAGE(PG8_SB(0, 1), cB + hstepB, voffB); PG8_STAGE(PG8_SA(0, 0), cA, voffA); PG8_STAGE(PG8_SA(0, 1), cA + hstepA, voffA);
    if (wr == 1) PG8_BAR;
    PG8_WAIT_V(2); PG8_BAR;
    PG8_STAGE(PG8_SB(1, 0), cB + kstep, voffB); PG8_STAGE(PG8_SA(1, 0), cA + kstep, voffA); PG8_STAGE(PG8_SB(1, 1), cB + hstepB + kstep, voffB);
    PG8_WAIT_V(6); PG8_BAR;
    for (;;) {
        const bool has_next = S.next(ui + 1, nxt);
        const char* nA = has_next ? (const char*)g.A + (size_t)nxt.pm * tstepA : cA; const char* nB = has_next ? (const char*)g.Bt + (size_t)nxt.pn * tstepB : cB;
        for (int t = 0; t < nt; t += 2) {
            const bool last = (t == nt - 2);
            const char* a1 = cA + PG8_KOFFA(t + 1);
            const char* a2 = last ? nA : cA + PG8_KOFFA(t + 2); const char* b2 = last ? nB : cB + (size_t)(t + 2) * kstep;
            const char* a3 = a2 + kstep; const char* b3 = b2 + kstep;
            PG8_LDB(B0, 0, 0); PG8_LDB(B1, 0, 1); PG8_SCHED; PG8_LDA(At, 0, 0); PG8_STAGE(PG8_SA(1, 1), a1 + hstepA, voffA);
            PG8_WAIT_V(8); PG8_WAIT_L(0); PG8_BAR; PG8_MMA(0, 0, At, B0); PG8_MMA(0, 1, At, B1); PG8_BAR; PG8_SCHED;
            PG8_LDA(At, 0, 1); PG8_STAGE(PG8_SB(0, 0), b2, voffB); PG8_STAGE(PG8_SB(0, 1), b2 + hstepB, voffB); PG8_STAGE(PG8_SA(0, 0), a2, voffA);
            PG8_WAIT_V(8); PG8_WAIT_L(0); PG8_BAR; PG8_MMA(1, 0, At, B0); PG8_MMA(1, 1, At, B1); PG8_BAR; PG8_SCHED;
            PG8_LDB(B0, 1, 0); PG8_LDB(B1, 1, 1); PG8_SCHED; PG8_LDA(At, 1, 0); PG8_STAGE(PG8_SA(0, 1), a2 + hstepA, voffA);
            PG8_WAIT_V(8); PG8_WAIT_L(0); PG8_BAR; PG8_MMA(0, 0, At, B0); PG8_MMA(0, 1, At, B1); PG8_BAR; PG8_SCHED;
            PG8_LDA(At, 1, 1); PG8_STAGE(PG8_SB(1, 0), b3, voffB); PG8_STAGE(PG8_SB(1, 1), b3 + hstepB, voffB); PG8_STAGE(PG8_SA(1, 0), a3, voffA);
            PG8_WAIT_V(8); PG8_WAIT_L(0); PG8_BAR; PG8_MMA(1, 0, At, B0); PG8_MMA(1, 1, At, B1); PG8_BAR; PG8_SCHED;
            if constexpr (Epi::HAS_MID) { if (!last && ((t + 2) & 15) == 0) { int fr_ = fr, fq_ = fq; asm volatile("" : "+v"(fr_), "+v"(fq_)); E.mid(acc, cur, (t + 2) >> 4, wr, wc, fr_, fq_); PG8_SCHED; } }
        }
        if (wr == 0) PG8_BAR;
        { int fr_ = fr, fq_ = fq; asm volatile("" : "+v"(fr_), "+v"(fq_)); E(acc, cur, wr, wc, fr_, fq_); }
        if (!has_next) break;
#pragma unroll
        for (int a = 0; a < 2; ++a)
#pragma unroll
            for (int b = 0; b < 2; ++b)
#pragma unroll
                for (int m = 0; m < 4; ++m)
#pragma unroll
                    for (int n = 0; n < 2; ++n) acc[a][b][m][n] = (f32x4){0.f, 0.f, 0.f, 0.f};
        cur = nxt; cA = nA; cB = nB; ++ui;
        if (wr == 1) PG8_BAR;
    }
    PG8_WAIT_V(0);
    PG8_BAR;
#undef PG8_KOFFA
#undef PG8_SA
#undef PG8_SB
#undef PG8_STAGE
#undef PG8_LDA
#undef PG8_LDB
#undef PG8_MMA
#undef PG8_WAIT_V
#undef PG8_WAIT_L
#undef PG8_BAR
#undef PG8_SCHED
}
}

__device__ __forceinline__ void transpose_item(const float* W, int N, int k0, int n0, bf16* WT, int Kd, int drow0, int dcol0, LAS float* scr, int lane) {
    float tv[32];
#pragma unroll
    for (int i = 0; i < 32; ++i) { const int kk = 2 * i + (lane >> 5); tv[i] = W[(size_t)(k0 + kk) * N + n0 + (lane & 31)]; }
#pragma unroll
    for (int i = 0; i < 32; ++i) { const int kk = 2 * i + (lane >> 5); scr[kk * 33 + (lane & 31)] = tv[i]; }
    if (0) for (int i = 0; i < 32; ++i) { const int kk = 2 * i + (lane >> 5); scr[kk * 33 + (lane & 31)] = W[(size_t)(k0 + kk) * N + n0 + (lane & 31)]; }
    LDS_WAIT();
    const int c = lane & 7;
#pragma unroll
    for (int j = 0; j < 4; ++j) { const int n = (lane >> 3) + 8 * j; const LAS float* s = scr + (8 * c) * 33 + n;
        u32x4 o; o.x = cvt_pk_bf16(s[0 * 33], s[1 * 33]); o.y = cvt_pk_bf16(s[2 * 33], s[3 * 33]); o.z = cvt_pk_bf16(s[4 * 33], s[5 * 33]); o.w = cvt_pk_bf16(s[6 * 33], s[7 * 33]);
        *(u32x4*)(WT + (size_t)(drow0 + n) * Kd + dcol0 + k0 + 8 * c) = o; }
    LDS_WAIT();
}
__device__ __forceinline__ void convert_ffn(const float* w1, const float* w3, const float* w2, unsigned char* ws, LAS float* scr, int gw, int ngw, int lane) {
    bf16* W13 = (bf16*)(ws + W_W13); bf16* W2 = (bf16*)(ws + W_W2);
    for (int it = gw; it < 4224; it += ngw) {
        if (it < 2816) { const int sel = it >= 1408, r = it - sel * 1408, kb = r / 88, nb = r % 88, n0 = 32 * nb;
            transpose_item(sel ? w3 : w1, DFF, 64 * kb, n0, W13, D, 256 * (n0 >> 7) + 128 * sel + (n0 & 127), 0, scr, lane); }
        else { const int r = it - 2816, kb = r / 32, nb = r % 32; transpose_item(w2, D, 64 * kb, 32 * nb, W2, DFF, 32 * nb, 0, scr, lane); }
    }
}
__device__ __forceinline__ void convert_mixer(const float* w_in, const float* p_ret, const float* p_conv, const float* p_swa, const float* w_out, unsigned char* ws, LAS float* scr, int gw, int ngw, int lane) {
    bf16* WIN = (bf16*)(ws + W_IN); bf16* PC = (bf16*)(ws + W_PCAT); bf16* WO = (bf16*)(ws + W_OUT);
    for (int it = gw; it < 7808; it += ngw) {
        if (it < 5760) { const int kb = it / 360, nb = it % 360, n0 = 32 * nb; int dr = n0;
            if (n0 >= 5120 && n0 < 6144) { const int ch = n0 - 5120; dr = 5120 + 256 * (ch >> 7) + (ch & 127); }
            else if (n0 >= 6144 && n0 < 7168) { const int ch = n0 - 6144; dr = 5120 + 256 * (ch >> 7) + 128 + (ch & 127); }
            transpose_item(w_in, INC, 64 * kb, n0, WIN, D, dr, 0, scr, lane); }
        else if (it < 7296) { const int r = it - 5760, sel = r / 512, q = r % 512, kb = q / 32, nb = q % 32;
            transpose_item(sel == 0 ? p_conv : (sel == 1 ? p_swa : p_ret), D, 64 * kb, 32 * nb, PC, 3 * D, 32 * nb, sel * D, scr, lane); }
        else { const int q = it - 7296, kb = q / 32, nb = q % 32; transpose_item(w_out, D, 64 * kb, 32 * nb, WO, D, 32 * nb, 0, scr, lane); }
    }
}
__device__ __forceinline__ void norm_rows(const void* hin, const int in_bf16, const float* gain, const float* sh, const float* sc, bf16* U, int gw, int ngw, int lane) {
    for (int blk = gw; blk < M / 16; blk += ngw) {
        const int r0 = blk * 16, b = r0 >> 12;
        f32x4 gm[4], sv[4];
#pragma unroll
        for (int j = 0; j < 4; ++j) { const int col = 4 * (64 * j + lane); const f32x4 g4 = *(const f32x4*)(gain + col), s4 = *(const f32x4*)(sc + (size_t)b * MODW + col);
            gm[j] = g4 * (s4 + 1.0f); sv[j] = *(const f32x4*)(sh + (size_t)b * MODW + col); }
        for (int r = r0; r < r0 + 16; r += 4) {
            f32x4 v[4][4]; float s[4];
#pragma unroll
            for (int q = 0; q < 4; ++q) {
                if (in_bf16) { const u32x2* xb = (const u32x2*)((const bf16*)hin + (size_t)(r + q) * D) + lane;
#pragma unroll
                    for (int j = 0; j < 4; ++j) { const u32x2 w = xb[64 * j]; v[q][j] = (f32x4){bf_lo(w.x), bf_hi(w.x), bf_lo(w.y), bf_hi(w.y)}; } }
                else { const f32x4* xr = (const f32x4*)((const float*)hin + (size_t)(r + q) * D) + lane;
#pragma unroll
                    for (int j = 0; j < 4; ++j) v[q][j] = xr[64 * j]; } }
#pragma unroll
            for (int q = 0; q < 4; ++q) { s[q] = 0.f;
#pragma unroll
                for (int j = 0; j < 4; ++j) s[q] += (v[q][j][0] * v[q][j][0] + v[q][j][1] * v[q][j][1]) + (v[q][j][2] * v[q][j][2] + v[q][j][3] * v[q][j][3]); }
#pragma unroll
            for (int o = 1; o < 64; o <<= 1) {
#pragma unroll
                for (int q = 0; q < 4; ++q) s[q] += __shfl_xor(s[q], o); }
#pragma unroll
            for (int q = 0; q < 4; ++q) { const float rstd = 1.0f / sqrtf(s[q] * (1.0f / D) + EPS);
                u32x2* o8 = (u32x2*)(U + (size_t)(r + q) * D) + lane;
#pragma unroll
                for (int j = 0; j < 4; ++j) { const f32x4 y = v[q][j] * rstd * gm[j] + sv[j]; u32x2 w; w.x = cvt_pk_bf16(y[0], y[1]); w.y = cvt_pk_bf16(y[2], y[3]); o8[64 * j] = w; } }
        }
    }
}
__device__ __forceinline__ void final_norm_rows(const float* h, float* outp, const float* gain, int gw, int ngw, int lane) {
    f32x4 gm[4];
#pragma unroll
    for (int j = 0; j < 4; ++j) gm[j] = *(const f32x4*)(gain + 4 * (64 * j + lane));
    for (int r0 = gw * 4; r0 < M; r0 += ngw * 4) {
        f32x4 v[4][4]; float s[4];
#pragma unroll
        for (int q = 0; q < 4; ++q) { const f32x4* xr = (const f32x4*)(h + (size_t)(r0 + q) * D) + lane;
#pragma unroll
            for (int j = 0; j < 4; ++j) v[q][j] = xr[64 * j]; }
#pragma unroll
        for (int q = 0; q < 4; ++q) { s[q] = 0.f;
#pragma unroll
            for (int j = 0; j < 4; ++j) s[q] += (v[q][j][0] * v[q][j][0] + v[q][j][1] * v[q][j][1]) + (v[q][j][2] * v[q][j][2] + v[q][j][3] * v[q][j][3]); }
#pragma unroll
        for (int o = 1; o < 64; o <<= 1) {
#pragma unroll
            for (int q = 0; q < 4; ++q) s[q] += __shfl_xor(s[q], o); }
#pragma unroll
        for (int q = 0; q < 4; ++q) { const float rstd = 1.0f / sqrtf(s[q] * (1.0f / D) + EPS); f32x4* xw = (f32x4*)(outp + (size_t)(r0 + q) * D) + lane;
#pragma unroll
            for (int j = 0; j < 4; ++j) xw[64 * j] = v[q][j] * rstd * gm[j]; }
    }
}
__device__ __forceinline__ void p0_phase(LAS unsigned char* lds, const float* c, const float* ada_w, const float* ada_b, unsigned char* ws, int vcu, int G, int tid, int lane, int wave) {
    LAS float* cact = (LAS float*)lds; LAS float* red = (LAS float*)(lds + 32768);
    for (int i = tid; i < BATCH * D; i += 512) cact[i] = silu_f(c[i]);
    WG_BAR();
    float* mod = (float*)(ws + WS_MOD);
    for (int item = vcu; item < 288; item += G) {
        const int l = item / 144, cb = item % 144;
        const float* W = ada_w + (size_t)l * D * MODW + 64 * cb + lane;
        float a[8];
#pragma unroll
        for (int b = 0; b < 8; ++b) a[b] = 0.f;
#pragma unroll 16
        for (int k = 128 * wave; k < 128 * wave + 128; ++k) { const float w = W[(size_t)k * MODW];
#pragma unroll
            for (int b = 0; b < 8; ++b) a[b] += cact[b * D + k] * w; }
#pragma unroll
        for (int b = 0; b < 8; ++b) red[(wave * 8 + b) * 64 + lane] = a[b];
        WG_BAR();
        { const int b = wave; float s = ada_b[(size_t)l * MODW + 64 * cb + lane];
#pragma unroll
            for (int wv = 0; wv < 8; ++wv) s += red[(wv * 8 + b) * 64 + lane];
            mod[((size_t)l * 8 + b) * MODW + 64 * cb + lane] = s; }
        WG_BAR();
    }
    f32x2* rot = (f32x2*)(ws + WS_ROT);
    for (int e = vcu * 512 + tid; e < SEQ * 128; e += G * 512) {
        const int pos = e >> 7, j = e & 127;
        const float lin = (float)j / 127.0f;
        const float inv = exp2f(-lin * 13.287712379549449f);
        const float ang = (float)pos * inv;
        float sn, cs; sincosf(ang, &sn, &cs);
        rot[e] = (f32x2){cs, sn};
    }
}

__device__ __forceinline__ void scan_phase(LAS unsigned char* lds, const bf16* RQ, const bf16* RK, const bf16* RV, bf16* RO, float* ssq, int vcu, int tid, int lane, int wave, const int pmode = 0) {
    constexpr int KROW = 528, VROW = 80, SROW = 528;
    LAS unsigned char* Ks = lds; LAS unsigned char* Vs = lds + 67584; LAS unsigned char* Vzs = Vs + 10240; LAS unsigned char* Ss0 = Vzs + 10240; LAS unsigned char* Ss1 = Ss0 + 16896;
    const int p = vcu >> 3, s = vcu & 7, b = p >> 2, h = p & 3;
    const int g = lane >> 4, c16 = lane & 15, q4 = (lane >> 2) & 3, p4 = lane & 3;
    const float lg = log2f(1.0f - exp2f(-5.0f - (float)h));
    const size_t tokbase = (size_t)b * SEQ;
    for (int i = tid; i < 16896 / 4; i += 512) ((LAS unsigned*)Ss0)[i] = 0u;
    f32x4 accS[2][2];
#pragma unroll
    for (int a = 0; a < 2; ++a)
#pragma unroll
        for (int c = 0; c < 2; ++c) accS[a][c] = (f32x4){0.f, 0.f, 0.f, 0.f};
    u32x4 kreg[8]; u32x4 vreg; bf16x8 qn[8];
    const int vrow = tid >> 2, vc16 = tid & 3;
#define SCAN_LOAD(n) do { const size_t t0_ = tokbase + (size_t)(n) * 128; \
        _Pragma("unroll") for (int i_ = 0; i_ < 8; ++i_) { const int c_ = tid + 512 * i_; kreg[i_] = *(const u32x4*)(RK + (t0_ + (c_ >> 5)) * D + 256 * h + (c_ & 31) * 8); } \
        vreg = *(const u32x4*)(RV + (t0_ + vrow) * D + 256 * h + 32 * s + vc16 * 8); \
        _Pragma("unroll") for (int ks_ = 0; ks_ < 8; ++ks_) qn[ks_] = *(const bf16x8*)(RQ + (t0_ + 16 * wave + c16) * D + 256 * h + 32 * ks_ + 8 * g); } while (0)
    SCAN_LOAD(0);
    int cur = 0;
    for (int n = 0; n < 32; ++n) {
        WG_BAR();
#pragma unroll
        for (int i = 0; i < 8; ++i) { const int c = tid + 512 * i; *(LAS u32x4*)(Ks + (c >> 5) * KROW + (c & 31) * 16) = kreg[i]; }
        *(LAS u32x4*)(Vs + vrow * VROW + vc16 * 16) = vreg;
        { const float z = exp2f(lg * (float)(127 - vrow)); u32x4 w;
            w.x = cvt_pk_bf16(bf_lo(vreg.x) * z, bf_hi(vreg.x) * z); w.y = cvt_pk_bf16(bf_lo(vreg.y) * z, bf_hi(vreg.y) * z);
            w.z = cvt_pk_bf16(bf_lo(vreg.z) * z, bf_hi(vreg.z) * z); w.w = cvt_pk_bf16(bf_lo(vreg.w) * z, bf_hi(vreg.w) * z);
            *(LAS u32x4*)(Vzs + vrow * VROW + vc16 * 16) = w; }
        bf16x8 qc[8];
#pragma unroll
        for (int ks = 0; ks < 8; ++ks) qc[ks] = qn[ks];
        const size_t tok0 = tokbase + (size_t)n * 128;
        if (n + 1 < 32 && !(pmode & 1)) SCAN_LOAD(n + 1);
        WG_BAR();
        LAS unsigned char* Sc = cur ? Ss1 : Ss0; LAS unsigned char* Sn = cur ? Ss0 : Ss1;
        const int i_loc = 16 * wave + c16;
        f32x4 accX[2], accI[2];
#pragma unroll
        for (int mt = 0; mt < 2; ++mt) { accX[mt] = (f32x4){0.f, 0.f, 0.f, 0.f}; accI[mt] = (f32x4){0.f, 0.f, 0.f, 0.f}; }
        {
#pragma unroll
            for (int kh = 0; kh < 4; ++kh) {
                bf16x8 fa[4];
#pragma unroll
                for (int k4 = 0; k4 < 2; ++k4)
#pragma unroll
                    for (int mt = 0; mt < 2; ++mt) fa[2 * k4 + mt] = *(const LAS bf16x8*)(Sc + (16 * mt + c16) * SROW + (32 * (2 * kh + k4) + 8 * g) * 2);
                asm volatile("" ::: "memory");
#pragma unroll
                for (int k4 = 0; k4 < 2; ++k4)
#pragma unroll
                    for (int mt = 0; mt < 2; ++mt) accX[mt] = mfma16(fa[2 * k4 + mt], qc[2 * kh + k4], accX[mt]);
            }
        }
        const int nkb = (pmode & 2) ? 0 : (wave >> 1) + 1;
        for (int kb = 0; kb < nkb; ++kb) {
            f32x4 st[2]; s16x4 vlo[2], vhi[2];
#pragma unroll
            for (int t = 0; t < 2; ++t) st[t] = (f32x4){0.f, 0.f, 0.f, 0.f};
#pragma unroll
            for (int kh = 0; kh < 4; ++kh) {
                bf16x8 fk[4];
#pragma unroll
                for (int k4 = 0; k4 < 2; ++k4)
#pragma unroll
                    for (int t = 0; t < 2; ++t) fk[2 * k4 + t] = *(const LAS bf16x8*)(Ks + (16 * (2 * kb + t) + c16) * KROW + (32 * (2 * kh + k4) + 8 * g) * 2);
                asm volatile("" ::: "memory");
#pragma unroll
                for (int k4 = 0; k4 < 2; ++k4)
#pragma unroll
                    for (int t = 0; t < 2; ++t) st[t] = mfma16(fk[2 * k4 + t], qc[2 * kh + k4], st[t]);
            }
            float pv[2][4];
#pragma unroll
            for (int t = 0; t < 2; ++t)
#pragma unroll
                for (int r = 0; r < 4; ++r) { const int d = i_loc - (16 * (2 * kb + t) + 4 * g + r); pv[t][r] = d >= 0 ? st[t][r] * __builtin_amdgcn_exp2f(lg * (float)d) : 0.f; }
            u32x4 pw; pw.x = cvt_pk_bf16(pv[0][0], pv[0][1]); pw.y = cvt_pk_bf16(pv[0][2], pv[0][3]); pw.z = cvt_pk_bf16(pv[1][0], pv[1][1]); pw.w = cvt_pk_bf16(pv[1][2], pv[1][3]);
            const bf16x8 pb = __builtin_bit_cast(bf16x8, pw);
#pragma unroll
            for (int mt = 0; mt < 2; ++mt) { vlo[mt] = tr_read(Vs + (32 * kb + 4 * g + q4) * VROW + (16 * mt + 4 * p4) * 2); vhi[mt] = tr_read(Vs + (32 * kb + 16 + 4 * g + q4) * VROW + (16 * mt + 4 * p4) * 2); }
#pragma unroll
            for (int mt = 0; mt < 2; ++mt) accI[mt] = mfma16(cat4(vlo[mt], vhi[mt]), pb, accI[mt]);
        }
        {
            const float xi = exp2f(lg * (float)(i_loc + 1)); float ss = 0.f;
#pragma unroll
            for (int mt = 0; mt < 2; ++mt) { const f32x4 o = accI[mt] + accX[mt] * xi; ss += (o[0] * o[0] + o[1] * o[1]) + (o[2] * o[2] + o[3] * o[3]);
                u32x2 w; w.x = cvt_pk_bf16(o[0], o[1]); w.y = cvt_pk_bf16(o[2], o[3]);
                *(u32x2*)(RO + (tok0 + i_loc) * D + 256 * h + 32 * s + 16 * mt + 4 * g) = w; }
            ss += __shfl_xor(ss, 16); ss += __shfl_xor(ss, 32);
            if (g == 0 && pmode == 0) ssq[((tok0 + i_loc) * 4 + h) * 8 + s] = ss;
        }
        {
            const float decay = exp2f(lg * 128.0f);
#pragma unroll
            for (int mt = 0; mt < 2; ++mt)
#pragma unroll
                for (int nt = 0; nt < 2; ++nt) accS[mt][nt] = accS[mt][nt] * decay;
#pragma unroll
            for (int k4 = 0; k4 < 4; ++k4) {
                bf16x8 Af[2], Bf[2];
#pragma unroll
                for (int mt = 0; mt < 2; ++mt) Af[mt] = cat4(tr_read(Vzs + (32 * k4 + 8 * g + q4) * VROW + (16 * mt + 4 * p4) * 2), tr_read(Vzs + (32 * k4 + 8 * g + 4 + q4) * VROW + (16 * mt + 4 * p4) * 2));
#pragma unroll
                for (int nt = 0; nt < 2; ++nt) Bf[nt] = cat4(tr_read(Ks + (32 * k4 + 8 * g + q4) * KROW + (32 * wave + 16 * nt + 4 * p4) * 2), tr_read(Ks + (32 * k4 + 8 * g + 4 + q4) * KROW + (32 * wave + 16 * nt + 4 * p4) * 2));
#pragma unroll
                for (int mt = 0; mt < 2; ++mt)
#pragma unroll
                    for (int nt = 0; nt < 2; ++nt) accS[mt][nt] = mfma16(Af[mt], Bf[nt], accS[mt][nt]);
            }
#pragma unroll
            for (int mt = 0; mt < 2; ++mt)
#pragma unroll
                for (int nt = 0; nt < 2; ++nt)
#pragma unroll
                    for (int r = 0; r < 4; ++r) *(LAS bf16*)(Sn + (16 * mt + 4 * g + r) * SROW + (32 * wave + 16 * nt + c16) * 2) = (bf16)(cvt_pk_bf16(accS[mt][nt][r], 0.f) & 0xffffu);
        }
        cur ^= 1;
    }
#undef SCAN_LOAD
    WG_BAR();
}

struct ConvRegs { u32x4 z0[2], z1[2], z2[2], cb[2]; };
__device__ __forceinline__ void conv_load(const bf16* CB, const bf16* Z, int idx, int nthr, int c8, ConvRegs& r) {
#pragma unroll
    for (int u = 0; u < 2; ++u) { const int t = (idx + u * nthr) >> 7, pos = t & (SEQ - 1);
        r.z0[u] = *(const u32x4*)(Z + (size_t)t * D + 8 * c8);
        r.z1[u] = (u32x4){0u, 0u, 0u, 0u}; r.z2[u] = (u32x4){0u, 0u, 0u, 0u};
        if (pos >= 1) r.z1[u] = *(const u32x4*)(Z + (size_t)(t - 1) * D + 8 * c8);
        if (pos >= 2) r.z2[u] = *(const u32x4*)(Z + (size_t)(t - 2) * D + 8 * c8);
        r.cb[u] = *(const u32x4*)(CB + (size_t)t * D + 8 * c8); }
}
__device__ __forceinline__ void conv_finish(bf16* Yb, const f32x4 (&cwv)[6], int idx, int nthr, int c8, const ConvRegs& r) {
#pragma unroll
    for (int u = 0; u < 2; ++u) { const int t = (idx + u * nthr) >> 7;
        float y[8];
        const unsigned zz0[4] = {r.z0[u].x, r.z0[u].y, r.z0[u].z, r.z0[u].w}, zz1[4] = {r.z1[u].x, r.z1[u].y, r.z1[u].z, r.z1[u].w}, zz2[4] = {r.z2[u].x, r.z2[u].y, r.z2[u].z, r.z2[u].w}, cc[4] = {r.cb[u].x, r.cb[u].y, r.cb[u].z, r.cb[u].w};
#pragma unroll
        for (int k = 0; k < 4; ++k) {
            const float wa0 = k < 2 ? cwv[0][2 * k] : cwv[1][2 * k - 4], wb0 = k < 2 ? cwv[0][2 * k + 1] : cwv[1][2 * k - 3];
            const float wa1 = k < 2 ? cwv[2][2 * k] : cwv[3][2 * k - 4], wb1 = k < 2 ? cwv[2][2 * k + 1] : cwv[3][2 * k - 3];
            const float wa2 = k < 2 ? cwv[4][2 * k] : cwv[5][2 * k - 4], wb2 = k < 2 ? cwv[4][2 * k + 1] : cwv[5][2 * k - 3];
            y[2 * k] = bf_lo(cc[k]) * (wa0 * bf_lo(zz2[k]) + wa1 * bf_lo(zz1[k]) + wa2 * bf_lo(zz0[k]));
            y[2 * k + 1] = bf_hi(cc[k]) * (wb0 * bf_hi(zz2[k]) + wb1 * bf_hi(zz1[k]) + wb2 * bf_hi(zz0[k]));
        }
        u32x4 w; w.x = cvt_pk_bf16(y[0], y[1]); w.y = cvt_pk_bf16(y[2], y[3]); w.z = cvt_pk_bf16(y[4], y[5]); w.w = cvt_pk_bf16(y[6], y[7]);
        *(u32x4*)(Yb + (size_t)t * D + 8 * c8) = w; }
}
__device__ __forceinline__ void swa_phase(LAS unsigned char* lds, const bf16* SQ, const bf16* SKV, bf16* Yc, const float* sinks, int vcu, int G, int tid, int lane, int wave,
                                          const bool fuse, const bf16* CB, const bf16* Z, const float* cw, bf16* Yb, int gtid, int nthr) {
    const int cc8 = gtid & 127; int cit = 0;
    f32x4 cwv[6];
#pragma unroll
    for (int j = 0; j < 3; ++j) { cwv[2 * j] = *(const f32x4*)(cw + j * D + 8 * cc8); cwv[2 * j + 1] = *(const f32x4*)(cw + j * D + 8 * cc8 + 4); }
    constexpr int ROWB = 144;
    LAS unsigned char* Ks = lds; LAS unsigned char* Vs = lds + 256 * ROWB;
    const int g = lane >> 4, c16 = lane & 15, q4 = (lane >> 2) & 3, p4 = lane & 3;
    for (int unit = vcu; unit < 512; unit += G) {
        const int b = unit >> 6, nb = (unit >> 1) & 31, kvh = unit & 1;
        const size_t tok_cur = (size_t)b * SEQ + 128 * nb, tok_prev = nb > 0 ? tok_cur - 128 : tok_cur;
        const bf16* qsrc = SQ + (tok_cur + 16 * wave + c16) * D + 64 * (8 * kvh) + 8 * g;
        bf16x8 qn0 = *(const bf16x8*)(qsrc), qn1 = *(const bf16x8*)(qsrc + 32);
        u32x4 kr[4], vr[4];
        { const int row = tid >> 1, half = tid & 1; const size_t tok = row < 128 ? tok_prev + row : tok_cur + (row - 128);
            const bf16* src = SKV + tok * 256 + 64 * kvh + 32 * half;
#pragma unroll
            for (int i = 0; i < 4; ++i) { kr[i] = *(const u32x4*)(src + 8 * i); vr[i] = *(const u32x4*)(src + 128 + 8 * i); }
            WG_BAR();
#pragma unroll
            for (int i = 0; i < 4; ++i) { *(LAS u32x4*)(Ks + row * ROWB + half * 64 + 16 * i) = kr[i]; *(LAS u32x4*)(Vs + row * ROWB + half * 64 + 16 * i) = vr[i]; }
        }
        WG_BAR();
        const int jt0 = 2 * (wave >> 1), iq = 16 * wave + c16;
        for (int hq = 0; hq < 8; ++hq) {
            const float sink = sinks[8 * kvh + hq];
            const bf16x8 q0 = qn0, q1 = qn1;
            int iqm = iq; asm volatile("" : "+v"(iqm));
            ConvRegs cr; const bool doconv = fuse && cit < 16;
            if (doconv) conv_load(CB, Z, gtid + cit * 2 * nthr, nthr, cc8, cr);
            if (hq < 7) { qn0 = *(const bf16x8*)(qsrc + 64 * (hq + 1)); qn1 = *(const bf16x8*)(qsrc + 64 * (hq + 1) + 32); }
            f32x4 st[10];
#pragma unroll
            for (int hf = 0; hf < 2; ++hf) {
                bf16x8 fk[10];
#pragma unroll
                for (int t = 0; t < 5; ++t)
#pragma unroll
                    for (int ks = 0; ks < 2; ++ks) fk[2 * t + ks] = *(const LAS bf16x8*)(Ks + (16 * (jt0 + 5 * hf + t) + c16) * ROWB + (32 * ks + 8 * g) * 2);
                asm volatile("" ::: "memory");
#pragma unroll
                for (int t = 0; t < 5; ++t) { st[5 * hf + t] = mfma16(fk[2 * t], q0, (f32x4){0.f, 0.f, 0.f, 0.f}); st[5 * hf + t] = mfma16(fk[2 * t + 1], q1, st[5 * hf + t]); }
            }
            float mx = sink;
#pragma unroll
            for (int t = 0; t < 10; ++t)
#pragma unroll
                for (int r = 0; r < 4; ++r) { const int j = 16 * (jt0 + t) + 4 * g + r, d = iqm + 128 - j; const bool valid = (d >= 0) && (d < 128) && (nb > 0 || j >= 128);
                    st[t][r] = valid ? st[t][r] : -INFINITY; mx = fmaxf(mx, st[t][r]); }
            mx = fmaxf(mx, __shfl_xor(mx, 16)); mx = fmaxf(mx, __shfl_xor(mx, 32));
            float sum = 0.f;
#pragma unroll
            for (int t = 0; t < 10; ++t)
#pragma unroll
                for (int r = 0; r < 4; ++r) { st[t][r] = __builtin_amdgcn_exp2f((st[t][r] - mx) * LOG2E); sum += st[t][r]; }
            sum += __shfl_xor(sum, 16); sum += __shfl_xor(sum, 32);
            const float inv = 1.0f / (sum + __builtin_amdgcn_exp2f((sink - mx) * LOG2E));
            f32x4 o[4];
#pragma unroll
            for (int dt = 0; dt < 4; ++dt) o[dt] = (f32x4){0.f, 0.f, 0.f, 0.f};
#pragma unroll
            for (int kbi = 0; kbi < 5; ++kbi) {
                u32x4 pw; pw.x = cvt_pk_bf16(st[2 * kbi][0], st[2 * kbi][1]); pw.y = cvt_pk_bf16(st[2 * kbi][2], st[2 * kbi][3]);
                pw.z = cvt_pk_bf16(st[2 * kbi + 1][0], st[2 * kbi + 1][1]); pw.w = cvt_pk_bf16(st[2 * kbi + 1][2], st[2 * kbi + 1][3]);
                const bf16x8 pb = __builtin_bit_cast(bf16x8, pw);
                s16x4 lo[4], hi[4];
#pragma unroll
                for (int dt = 0; dt < 4; ++dt) { lo[dt] = tr_read(Vs + (16 * (jt0 + 2 * kbi) + 4 * g + q4) * ROWB + (16 * dt + 4 * p4) * 2); hi[dt] = tr_read(Vs + (16 * (jt0 + 2 * kbi + 1) + 4 * g + q4) * ROWB + (16 * dt + 4 * p4) * 2); }
                asm volatile("" ::: "memory");
#pragma unroll
                for (int dt = 0; dt < 4; ++dt) o[dt] = mfma16(cat4(lo[dt], hi[dt]), pb, o[dt]);
            }
#pragma unroll
            for (int dt = 0; dt < 4; ++dt) { u32x2 w; w.x = cvt_pk_bf16(o[dt][0] * inv, o[dt][1] * inv); w.y = cvt_pk_bf16(o[dt][2] * inv, o[dt][3] * inv);
                *(u32x2*)(Yc + (tok_cur + iq) * D + 64 * (8 * kvh + hq) + 16 * dt + 4 * g) = w; }
            if (doconv) conv_finish(Yb, cwv, gtid + cit * 2 * nthr, nthr, cc8, cr);
            ++cit;
        }
    }
    WG_BAR();
}
__device__ __forceinline__ void ya_pass(const bf16* R, const bf16* RG, const float* ssq, bf16* Ya, int gtid, int nthr) {
    for (int idx = gtid; idx < M * 128; idx += 2 * nthr) {
        u32x4 r[2], gq[2]; f32x4 s0[2], s1[2];
#pragma unroll
        for (int u = 0; u < 2; ++u) { const int i = idx + u * nthr, t = i >> 7, c8 = i & 127, h = c8 >> 5;
            const f32x4* sp = (const f32x4*)(ssq + ((size_t)t * 4 + h) * 8); s0[u] = sp[0]; s1[u] = sp[1];
            r[u] = *(const u32x4*)(R + (size_t)t * D + 8 * c8); gq[u] = *(const u32x4*)(RG + (size_t)t * D + 8 * c8); }
#pragma unroll
        for (int u = 0; u < 2; ++u) { const int i = idx + u * nthr, t = i >> 7, c8 = i & 127;
            const float tot = ((s0[u][0] + s0[u][1]) + (s0[u][2] + s0[u][3])) + ((s1[u][0] + s1[u][1]) + (s1[u][2] + s1[u][3]));
            const float rstd = 1.0f / sqrtf(tot * (1.0f / 256.0f) + EPS);
            u32x4 w;
            w.x = cvt_pk_bf16(bf_lo(gq[u].x) * (bf_lo(r[u].x) * rstd), bf_hi(gq[u].x) * (bf_hi(r[u].x) * rstd)); w.y = cvt_pk_bf16(bf_lo(gq[u].y) * (bf_lo(r[u].y) * rstd), bf_hi(gq[u].y) * (bf_hi(r[u].y) * rstd));
            w.z = cvt_pk_bf16(bf_lo(gq[u].z) * (bf_lo(r[u].z) * rstd), bf_hi(gq[u].z) * (bf_hi(r[u].z) * rstd)); w.w = cvt_pk_bf16(bf_lo(gq[u].w) * (bf_lo(r[u].w) * rstd), bf_hi(gq[u].w) * (bf_hi(r[u].w) * rstd));
            *(u32x4*)(Ya + (size_t)t * D + 8 * c8) = w; }
    }
}
__device__ __forceinline__ void conv_pass(const bf16* CB, const bf16* Z, const float* cw, bf16* Yb, int gtid, int nthr) {
    const int c8 = gtid & 127;
    const f32x4 w0a = *(const f32x4*)(cw + 8 * c8), w0b = *(const f32x4*)(cw + 8 * c8 + 4), w1a = *(const f32x4*)(cw + D + 8 * c8), w1b = *(const f32x4*)(cw + D + 8 * c8 + 4),
                w2a = *(const f32x4*)(cw + 2 * D + 8 * c8), w2b = *(const f32x4*)(cw + 2 * D + 8 * c8 + 4);
    for (int idx = gtid; idx < M * 128; idx += 2 * nthr) {
        u32x4 z0[2], z1[2], z2[2], cbv[2];
#pragma unroll
        for (int u = 0; u < 2; ++u) { const int t = (idx + u * nthr) >> 7, pos = t & (SEQ - 1);
            z0[u] = *(const u32x4*)(Z + (size_t)t * D + 8 * c8);
            z1[u] = (u32x4){0u, 0u, 0u, 0u}; z2[u] = (u32x4){0u, 0u, 0u, 0u};
            if (pos >= 1) z1[u] = *(const u32x4*)(Z + (size_t)(t - 1) * D + 8 * c8);
            if (pos >= 2) z2[u] = *(const u32x4*)(Z + (size_t)(t - 2) * D + 8 * c8);
            cbv[u] = *(const u32x4*)(CB + (size_t)t * D + 8 * c8); }
#pragma unroll
        for (int u = 0; u < 2; ++u) { const int t = (idx + u * nthr) >> 7;
            float y[8];
            const unsigned zz0[4] = {z0[u].x, z0[u].y, z0[u].z, z0[u].w}, zz1[4] = {z1[u].x, z1[u].y, z1[u].z, z1[u].w}, zz2[4] = {z2[u].x, z2[u].y, z2[u].z, z2[u].w}, cc[4] = {cbv[u].x, cbv[u].y, cbv[u].z, cbv[u].w};
#pragma unroll
            for (int k = 0; k < 4; ++k) {
                const float wa0 = k < 2 ? w0a[2 * k] : w0b[2 * k - 4], wb0 = k < 2 ? w0a[2 * k + 1] : w0b[2 * k - 3];
                const float wa1 = k < 2 ? w1a[2 * k] : w1b[2 * k - 4], wb1 = k < 2 ? w1a[2 * k + 1] : w1b[2 * k - 3];
                const float wa2 = k < 2 ? w2a[2 * k] : w2b[2 * k - 4], wb2 = k < 2 ? w2a[2 * k + 1] : w2b[2 * k - 3];
                y[2 * k] = bf_lo(cc[k]) * (wa0 * bf_lo(zz2[k]) + wa1 * bf_lo(zz1[k]) + wa2 * bf_lo(zz0[k]));
                y[2 * k + 1] = bf_hi(cc[k]) * (wb0 * bf_hi(zz2[k]) + wb1 * bf_hi(zz1[k]) + wb2 * bf_hi(zz0[k]));
            }
            u32x4 w; w.x = cvt_pk_bf16(y[0], y[1]); w.y = cvt_pk_bf16(y[2], y[3]); w.z = cvt_pk_bf16(y[4], y[5]); w.w = cvt_pk_bf16(y[6], y[7]);
            *(u32x4*)(Yb + (size_t)t * D + 8 * c8) = w; }
    }
}

#define RLX_AGENT __ATOMIC_RELAXED, __HIP_MEMORY_SCOPE_AGENT
#define XB_TMO      128
#define XB_XCNT(j)  (256  + 64 * (j))
#define XB_XSUB(j)  (1280 + 64 * (j))
#define XB_XGEN(j)  (2304 + 64 * (j))
#define XB_TOP      3328
#define XB_TOPGEN   3392
#define XCD_BAR_WORDS 3456
#define XB_SPIN_CAP (1u << 18)

__device__ __forceinline__ unsigned xb_ld(unsigned* p)              { return __hip_atomic_load(p, __ATOMIC_RELAXED, __HIP_MEMORY_SCOPE_AGENT); }
__device__ __forceinline__ unsigned xb_add(unsigned* p, unsigned v) { return __hip_atomic_fetch_add(p, v, __ATOMIC_RELAXED, __HIP_MEMORY_SCOPE_AGENT); }
__device__ __forceinline__ unsigned xb_xcc_id() { return (unsigned)__builtin_amdgcn_s_getreg((3 << 11) | 20) & 0xFu; }
#define XB_SPIN(cond, bar) do { unsigned _sp = 0; while (cond) { __builtin_amdgcn_s_sleep(1); \
    if ((++_sp & 255u) == 0u) { if (xb_ld(&(bar)[XB_TMO])) break; if (_sp > XB_SPIN_CAP) { atomicAdd(&(bar)[XB_TMO], 1u); break; } } } } while (0)

struct XcdBarrier {
    unsigned* bar; unsigned x;
    volatile LAS unsigned* st;
};

__device__ __forceinline__ XcdBarrier xcd_barrier_post(unsigned* bar, volatile LAS unsigned* st) {
    XcdBarrier b; b.bar = bar; b.x = xb_xcc_id(); b.st = st;
    if (threadIdx.x == 0) (void)xb_add(&bar[XB_XCNT(b.x)], 1u);
    return b;
}
__device__ __forceinline__ void xcd_barrier_complete(unsigned* bar, unsigned x, unsigned& nloc, unsigned& nx) {
    const unsigned G = gridDim.x * gridDim.y * gridDim.z;
    unsigned sum, cnt, mine, sp = 0u;
    for (;;) {
        sum = 0u; cnt = 0u; mine = 0u;
#pragma unroll
        for (unsigned j = 0; j < 16; ++j) { const unsigned c = xb_ld(&bar[XB_XCNT(j)]); sum += c; cnt += (c > 0u) ? 1u : 0u; mine = (j == x) ? c : mine; }
        if (sum == G) break;
        __builtin_amdgcn_s_sleep(1);
        if ((++sp & 255u) == 0u) { if (xb_ld(&bar[XB_TMO])) break; if (sp > XB_SPIN_CAP) { atomicAdd(&bar[XB_TMO], 1u); break; } }
    }
    nloc = mine > 0u ? mine : 1u; nx = cnt > 0u ? cnt : 1u;
}

__device__ __forceinline__ void xcd_barrier(const XcdBarrier& b) {
    asm volatile("s_waitcnt vmcnt(0)" ::: "memory");
    __syncthreads();
    if (threadIdx.x == 0) {
        unsigned* bar = b.bar;
        __builtin_amdgcn_s_waitcnt(0);
        unsigned nloc = b.st[0], nx = b.st[1];
        if (nloc == 0u) { xcd_barrier_complete(bar, b.x, nloc, nx); b.st[0] = nloc; b.st[1] = nx; }
        const unsigned old = xb_add(&bar[XB_XSUB(b.x)], 1u);
        const unsigned gen = old / nloc;
        if (old + 1u == (gen + 1u) * nloc) {
            __builtin_amdgcn_fence(__ATOMIC_RELEASE, "agent");
            asm volatile("s_waitcnt vmcnt(0)" ::: "memory");
            const unsigned og = xb_add(&bar[XB_TOP], 1u);
            const unsigned tg = og / nx;
            if (og + 1u == (tg + 1u) * nx) xb_add(&bar[XB_TOPGEN], 1u);
            else XB_SPIN(xb_ld(&bar[XB_TOPGEN]) == tg, bar);
            __builtin_amdgcn_fence(__ATOMIC_ACQUIRE, "agent");
            xb_add(&bar[XB_XGEN(b.x)], 1u);
            asm volatile("s_waitcnt vmcnt(0)" ::: "memory");
        } else {
            XB_SPIN(xb_ld(&bar[XB_XGEN(b.x)]) == gen, bar);
            __builtin_amdgcn_fence(__ATOMIC_ACQUIRE, "agent");
            asm volatile("s_waitcnt vmcnt(0)" ::: "memory");
        }
    }
    __syncthreads();
}

struct Args { const float* in[21]; float* out; unsigned char* ws; int ph_lo, ph_hi, dump_mib, pad; };

__global__ void __launch_bounds__(512) hybrid_fwd(Args a) {
    extern __shared__ __attribute__((aligned(16))) unsigned char lds_raw[];
    LAS unsigned char* lds = (LAS unsigned char*)lds_raw;
#if MK_ONE_LAUNCH
    if (threadIdx.x < 2) ((volatile LAS unsigned*)(lds + MISC_OFF))[threadIdx.x] = 0u;
    __syncthreads();
    const XcdBarrier xbar = xcd_barrier_post((unsigned*)a.ws + CW_BAR, (volatile LAS unsigned*)(lds + MISC_OFF));
#endif
    for (int ph = a.ph_lo; ph < a.ph_hi; ++ph) {
        int tid = threadIdx.x; asm volatile("" : "+v"(tid));
        int G = gridDim.x, bx = blockIdx.x; asm volatile("" : "+s"(G), "+s"(bx));
        const int vcu = (G % 8 == 0) ? (bx % 8) * (G / 8) + bx / 8 : bx;
        const int lane = tid & 63, wave = __builtin_amdgcn_readfirstlane(tid >> 6);
        const int gw = vcu * 8 + wave, ngw = G * 8, gtid = vcu * 512 + tid, nthr = G * 512;
        const __attribute__((address_space(4))) Args* ap = (const __attribute__((address_space(4))) Args*)__builtin_amdgcn_kernarg_segment_ptr(); asm volatile("" : "+s"(ap));
        unsigned char* ws = ap->ws;
        bf16* H = (bf16*)ap->out;
        float* HF = (float*)(ws + WS_BIG + 176 * MiB);
        const float* mod = (const float*)(ws + WS_MOD);
        LAS float* scr = (LAS float*)(lds + wave * 8448);
        bf16* U = (bf16*)(ws + WS_U);
        unsigned char* big = ws + WS_BIG;
        bf16* Yb = (bf16*)(ws + WS_Y); bf16* Yc = (bf16*)(ws + WS_Y + PLANE); bf16* Ya = (bf16*)(ws + WS_Y + 2 * PLANE);
#if MK_ONE_LAUNCH
        if (ph > a.ph_lo) { if (a.ph_lo != 0 && ph == a.ph_lo + 1) cg::this_grid().sync(); else xcd_barrier(xbar); }
#endif
        if (ph == 100) {
            const bf16* src = (const bf16*)(ap->ws + (size_t)ap->dump_mib * MiB); float* o = ap->out;
            for (int i = vcu * 512 + tid; i < M * D; i += G * 512) o[i] = __uint_as_float(((unsigned)src[i]) << 16);
            continue; }
        if (ph == 0) { p0_phase(lds, ap->in[1], ap->in[2], ap->in[3], ws, vcu, G, tid, lane, wave); continue; }
        if (ph == NPHASE - 1) { final_norm_rows(HF, ap->out, ap->in[20], gw, ngw, lane); continue; }
#ifndef MK_DUP_NOP
#define MK_DUP_NOP 0
#endif
#ifdef MK_DUP_K
        const int l = (ph - 1) / 15, slot_ = (ph - 1) % 15, k = slot_ <= MK_DUP_K ? slot_ : slot_ - 1;
        const bool dupnop = (slot_ == MK_DUP_K + 1) && MK_DUP_NOP;
#else
        const int l = (ph - 1) / 14, k = (ph - 1) % 14;
        const bool dupnop = false;
#endif
        const float* modl = mod + (size_t)l * 8 * MODW;
        if (k == 1 || k == 12) {
            const pg8::Gemm g{U, (const bf16*)(ws + W_W13), M, 2 * DFF, D, D, 30, 0}; const pg8::EpiUp eu{(bf16*)big, dupnop};
            pg8::StaticOrder S; S.init(M, 2 * DFF, G, bx); pg8::gemm_phase<pg8::EpiUp>(lds, g, S, eu, tid);
        } else if (k == 2 || k == 13 || k == 10) {
            const bool wo = (k == 10); const int KK = wo ? D : DFF;
            const pg8::Gemm g{wo ? (const bf16*)U : (const bf16*)big, (const bf16*)(ws + (wo ? W_OUT : W_W2)), M, D, KK, KK, 30, 0};
            const bool first = (l == 0 && k == 2), lastres = (l == 1 && k == 13);
            const pg8::EpiRes er{first ? (const void*)ap->in[0] : (const void*)H, lastres ? (void*)HF : (void*)H, modl + (k == 2 ? 2 : (wo ? 5 : 8)) * D, wo ? 1.0f : 0.5f, first ? 0 : 1, lastres ? 0 : 1};
            pg8::StaticOrder S; S.init(M, D, G, bx); pg8::gemm_phase<pg8::EpiRes>(lds, g, S, er, tid);
        } else if (k == 4 || k == 6 || k == 8) {
            const int grp = k == 4 ? 0 : (k == 6 ? 1 : 2), roff = grp == 0 ? 0 : (grp == 1 ? 4096 : 8448), NN = grp == 0 ? 4096 : (grp == 1 ? 4352 : 3072);
            if (k == 6) { if (G == 256) { if (bx >= 128) ya_pass(Ya, (const bf16*)(big + 208 * MiB), (const float*)(ws + WS_SSQ), Ya, (bx - 128) * 512 + tid, 128 * 512); }
                          else ya_pass(Ya, (const bf16*)(big + 208 * MiB), (const float*)(ws + WS_SSQ), Ya, gtid, nthr); }
            const pg8::Gemm g{U, (const bf16*)(ws + W_IN) + (size_t)roff * D, M, NN, D, D, 30, 0}; const pg8::EpiProj ep{big, grp, (const float*)(ws + WS_ROT)};
            pg8::StaticOrder S; S.init(M, NN, G, bx); pg8::gemm_phase<pg8::EpiProj>(lds, g, S, ep, tid);
        } else if (k == 9) {
            const pg8::Gemm g{Yb, (const bf16*)(ws + W_PCAT), M, D, 3 * D, D, 4, PLANE}; const pg8::EpiMerge em{(const bf16*)big, U};
            pg8::StaticOrder S; S.init(M, D, G, bx); pg8::gemm_phase<pg8::EpiMerge>(lds, g, S, em, tid);
        } else if (k == 0) {
            norm_rows(l == 0 ? (const void*)ap->in[0] : (const void*)H, l == 0 ? 0 : 1, ap->in[4] + (size_t)l * D, modl + 0 * D, modl + 1 * D, U, gw, ngw, lane);
            convert_ffn(ap->in[5] + (size_t)l * D * DFF, ap->in[6] + (size_t)l * D * DFF, ap->in[7] + (size_t)l * D * DFF, ws, scr, gw, ngw, lane);
        } else if (k == 3) {
            norm_rows(H, 1, ap->in[8] + (size_t)l * D, modl + 3 * D, modl + 4 * D, U, gw, ngw, lane);
            convert_mixer(ap->in[9] + (size_t)l * D * INC, ap->in[12] + (size_t)l * D * D, ap->in[13] + (size_t)l * D * D, ap->in[14] + (size_t)l * D * D, ap->in[15] + (size_t)l * D * D, ws, scr, gw, ngw, lane);
        } else if (k == 11) {
            norm_rows(H, 1, ap->in[16] + (size_t)l * D, modl + 6 * D, modl + 7 * D, U, gw, ngw, lane);
            convert_ffn(ap->in[17] + (size_t)l * D * DFF, ap->in[18] + (size_t)l * D * DFF, ap->in[19] + (size_t)l * D * DFF, ws, scr, gw, ngw, lane);
        } else if (k == 5) {
#ifdef MK_SCAN_PMODE
            if (dupnop) scan_phase(lds, (const bf16*)big, (const bf16*)(big + PLANE), (const bf16*)(big + 2 * PLANE), Yc, (float*)(ws + WS_SSQ), vcu, tid, lane, wave, MK_SCAN_PMODE);
            else
#endif
            scan_phase(lds, (const bf16*)big, (const bf16*)(big + PLANE), (const bf16*)(big + 2 * PLANE), Ya, (float*)(ws + WS_SSQ), vcu, tid, lane, wave);
        } else if (k == 7) {
            const bool fuse = (G == 256);
            swa_phase(lds, (const bf16*)(big + 2 * PLANE), (const bf16*)(big + 3 * PLANE), Yc, ap->in[11] + (size_t)l * 16, vcu, G, tid, lane, wave,
                      fuse, (const bf16*)big, (const bf16*)(big + PLANE), ap->in[10] + (size_t)l * 3 * D, Yb, gtid, nthr);
            if (!fuse) conv_pass((const bf16*)big, (const bf16*)(big + PLANE), ap->in[10] + (size_t)l * 3 * D, Yb, gtid, nthr);
        }
    }
}

extern "C" void kernel_launch(void* const* d_in, const int* in_sizes, int n_in, void* d_out, int out_size, void* d_ws, size_t ws_size, hipStream_t stream) {
    static int grid = 0;
    if (grid == 0) {
        if (n_in != 21 || in_sizes[0] != M * D || out_size != M * D || ws_size < WS_END) { fprintf(stderr, "kernel_launch: unexpected shapes / workspace (n_in %d, in0 %d, out %d, ws %zu < %zu)\n", n_in, n_in > 0 ? in_sizes[0] : -1, out_size, ws_size, (size_t)WS_END); grid = -1; return; }
        if (hipFuncSetAttribute((const void*)hybrid_fwd, hipFuncAttributeMaxDynamicSharedMemorySize, LDS_BYTES) != hipSuccess) { fprintf(stderr, "kernel_launch: hipFuncSetAttribute failed\n"); grid = -1; return; }
        int dev = 0, cus = 0, per_cu = 0;
        (void)hipGetDevice(&dev); (void)hipDeviceGetAttribute(&cus, hipDeviceAttributeMultiprocessorCount, dev);
        (void)hipOccupancyMaxActiveBlocksPerMultiprocessor(&per_cu, (const void*)hybrid_fwd, 512, LDS_BYTES);
        (void)hipGetLastError();
        if (per_cu < 1) { fprintf(stderr, "kernel_launch: occupancy query says %d blocks per CU\n", per_cu); per_cu = 1; }
        grid = cus * 1;
        if (grid != 256) fprintf(stderr, "kernel_launch: note: %d CUs\n", grid);
    }
    if (grid < 0) return;
    Args a{};
    for (int i = 0; i < 21; ++i) a.in[i] = (const float*)d_in[i];
    a.out = (float*)d_out; a.ws = (unsigned char*)d_ws;
#if MK_ONE_LAUNCH
    if (hipMemsetAsync(d_ws, 0, CTL_ZERO_BYTES, stream) != hipSuccess) { fprintf(stderr, "kernel_launch: hipMemsetAsync failed\n"); return; }
    a.ph_lo = 0; a.ph_hi = NPHASE;
    void* args[] = {&a};
    hipError_t e = hipLaunchCooperativeKernel((const void*)hybrid_fwd, dim3(grid), dim3(512), args, LDS_BYTES, stream);
    if (e != hipSuccess) fprintf(stderr, "kernel_launch: cooperative launch failed: %s (grid %d)\n", hipGetErrorString(e), grid);
#else
#ifndef MK_CUT
#define MK_CUT NPHASE
#endif
    for (int ph = 0; ph < MK_CUT; ++ph) { a.ph_lo = ph; a.ph_hi = ph + 1; hipLaunchKernelGGL(hybrid_fwd, dim3(grid), dim3(512), LDS_BYTES, stream, a); }
#ifdef MK_DUMP
    a.ph_lo = 100; a.ph_hi = 101; a.dump_mib = MK_DUMP; hipLaunchKernelGGL(hybrid_fwd, dim3(grid), dim3(512), LDS_BYTES, stream, a);
#endif
#endif
}
```

```cpp
#include <hip/hip_runtime.h>
#include <hip/hip_cooperative_groups.h>
#include <cstdio>
#include <cstdint>
namespace cg = cooperative_groups;

#ifndef MK_ONE_LAUNCH
#define MK_ONE_LAUNCH 1
#endif

#define LAS __attribute__((address_space(3)))
typedef unsigned short bf16;
typedef short bf16x8 __attribute__((ext_vector_type(8)));
typedef short s16x4 __attribute__((ext_vector_type(4)));
typedef float f32x4 __attribute__((ext_vector_type(4)));
typedef float f32x2 __attribute__((ext_vector_type(2)));
typedef unsigned u32x4 __attribute__((ext_vector_type(4)));
typedef unsigned u32x2 __attribute__((ext_vector_type(2)));

constexpr int D = 1024, BATCH = 8, SEQ = 4096, M = BATCH * SEQ, DFF = 2816, INC = 11520, MODW = 9 * D;
constexpr float EPS = 1e-6f;
constexpr float LOG2E = 1.4426950408889634f;
constexpr size_t MiB = 1u << 20;
constexpr size_t WS_MOD = 1 * MiB;
constexpr size_t WS_ROT = 2 * MiB;
constexpr size_t WS_SSQ = 6 * MiB;
constexpr size_t WS_W = 10 * MiB;
constexpr size_t W_W13 = WS_W, W_W2 = WS_W + 11 * MiB;
constexpr size_t W_IN = WS_W, W_PCAT = WS_W + 23 * MiB, W_OUT = WS_W + 29 * MiB;
constexpr size_t WS_U = 42 * MiB;
constexpr size_t WS_BIG = 106 * MiB;
constexpr size_t PLANE = 64 * MiB;
constexpr size_t WS_Y = WS_BIG + 208 * MiB;
constexpr size_t WS_END = WS_Y + 3 * PLANE;
constexpr int LDS_BYTES = 147456;
#ifdef MK_DUP_K
constexpr int NPHASE = 32;
#else
constexpr int NPHASE = 30;
#endif
constexpr int CW_BAR = 4096;
constexpr size_t CTL_ZERO_BYTES = 65536;
constexpr int MISC_OFF = 131072 + 64;

typedef __bf16 bf16x2_t __attribute__((ext_vector_type(2)));
__device__ __forceinline__ unsigned cvt_pk_bf16(float lo, float hi) { const f32x2 v = {lo, hi}; const bf16x2_t b = __builtin_convertvector(v, bf16x2_t); return __builtin_bit_cast(unsigned, b); }
__device__ __forceinline__ float bf_lo(unsigned w) { return __uint_as_float(w << 16); }
__device__ __forceinline__ float bf_hi(unsigned w) { return __uint_as_float(w & 0xffff0000u); }
__device__ __forceinline__ float silu_f(float x) { return x * __builtin_amdgcn_rcpf(1.0f + __builtin_amdgcn_exp2f(-LOG2E * x)); }
__device__ __forceinline__ float sigmoid_f(float x) { return __builtin_amdgcn_rcpf(1.0f + __builtin_amdgcn_exp2f(-LOG2E * x)); }
__device__ __forceinline__ f32x4 mfma16(bf16x8 a, bf16x8 b, f32x4 c) { return __builtin_amdgcn_mfma_f32_16x16x32_bf16(a, b, c, 0, 0, 0); }
typedef short v4i16_t __attribute__((ext_vector_type(4)));
__device__ __forceinline__ s16x4 tr_read(LAS const unsigned char* p) { return __builtin_bit_cast(s16x4, __builtin_amdgcn_ds_read_tr16_b64_v4i16((LAS v4i16_t*)p)); }
__device__ __forceinline__ bf16x8 cat4(s16x4 lo, s16x4 hi) { return (bf16x8){lo[0], lo[1], lo[2], lo[3], hi[0], hi[1], hi[2], hi[3]}; }
#define LDS_WAIT() asm volatile("s_waitcnt lgkmcnt(0)" ::: "memory")
#define WG_BAR() do { asm volatile("s_waitcnt lgkmcnt(0)" ::: "memory"); __builtin_amdgcn_s_barrier(); asm volatile("" ::: "memory"); } while (0)
__device__ __forceinline__ float wave_sum(float v) {
#pragma unroll
    for (int o = 1; o < 64; o <<= 1) v += __shfl_xor(v, o);
    return v;
}

namespace pg8 {
constexpr int BM = 256, BK = 64, HALF = 128, HTB = HALF * BK * 2, STAGE_BYTES = 8 * HTB, NXCD = 8, WGM = 8;
__host__ __device__ __forceinline__ int lds_byte(int r, int c) { const int st = (r >> 4) * 2 + (c >> 5), rr = r & 15, cc = c & 31, ob = rr * 64 + cc * 2; return st * 1024 + (ob ^ (((ob >> 9) & 1) << 5)); }
__host__ __device__ __forceinline__ void stage_rc(int b, int& R, int& C) { const int st = b / 1024, sb = b % 1024, swz = sb ^ (((sb >> 9) & 1) << 5); R = (st >> 1) * 16 + swz / 64; C = (st & 1) * 32 + (swz % 64) / 2; }
__host__ __device__ __forceinline__ int perm32(int rho) { const int n = rho >> 4, i = rho & 15; return 8 * (i >> 2) + 4 * n + (i & 3); }

struct Unit { int pm, pn; };
struct Gemm { const bf16* A; const bf16* Bt; int M, N, K, lda, segShift; size_t segStride; };

struct StaticOrder {
    int nM, nN, nwg, G, c;
    __device__ void init(int M_, int N_, int G_, int c_) { nM = M_ / BM; nN = N_ / BM; nwg = nM * nN; G = G_; c = c_; }
    __device__ bool next(int i, Unit& u) const {
        const long L = (long)i * G + c; if (L >= nwg) return false;
        int wgid = (int)L; { const int q = nwg / NXCD, r = nwg % NXCD, xcd = wgid % NXCD, off = wgid / NXCD; wgid = (xcd < r ? xcd * (q + 1) : r * (q + 1) + (xcd - r) * q) + off; }
        const int nig = WGM * nN, gid = wgid / nig, fm = gid * WGM, gsz = (nM - fm) < WGM ? (nM - fm) : WGM;
        u.pm = fm + ((wgid % nig) % gsz); u.pn = (wgid % nig) / gsz; return true;
    }
};

typedef f32x4 Acc[2][2][4][2];

struct EpiUp {
    static constexpr bool PERM = true, HAS_MID = false;
    bf16* O; bool nop;
    __device__ __forceinline__ void mid(Acc&, const Unit&, int, int, int, int, int) const {}
    __device__ __forceinline__ void operator()(const Acc& acc, const Unit& u, int wr, int wc, int fr, int fq) const {
        if (nop) return;
        const int row0 = u.pm * BM + wr * 64 + fr, col0 = u.pn * 128 + wc * 32 + 8 * fq;
#pragma unroll
        for (int ai = 0; ai < 2; ++ai)
#pragma unroll
            for (int m = 0; m < 4; ++m) {
                bf16* rowp = O + (size_t)(row0 + ai * HALF + m * 16) * DFF + col0;
                const f32x4 a0 = acc[ai][0][m][0], a1 = acc[ai][0][m][1], b0 = acc[ai][1][m][0], b1 = acc[ai][1][m][1];
                u32x4 w;
                w.x = cvt_pk_bf16(silu_f(a0[0]) * b0[0], silu_f(a0[1]) * b0[1]); w.y = cvt_pk_bf16(silu_f(a0[2]) * b0[2], silu_f(a0[3]) * b0[3]);
                w.z = cvt_pk_bf16(silu_f(a1[0]) * b1[0], silu_f(a1[1]) * b1[1]); w.w = cvt_pk_bf16(silu_f(a1[2]) * b1[2], silu_f(a1[3]) * b1[3]);
                *(u32x4*)rowp = w;
            }
    }
};
struct EpiRes {
    static constexpr bool PERM = true, HAS_MID = false;
    const void* Hin; void* Hout; const float* gate; float coef; int in_bf16, out_bf16;
    __device__ __forceinline__ void mid(Acc&, const Unit&, int, int, int, int, int) const {}
    __device__ __forceinline__ void operator()(const Acc& acc, const Unit& u, int wr, int wc, int fr, int fq) const {
        const int row0 = u.pm * BM + wr * 64 + fr, col0 = u.pn * BM + wc * 32 + 8 * fq, b = u.pm >> 4;
        f32x4 gv[2][2];
#pragma unroll
        for (int bj = 0; bj < 2; ++bj)
#pragma unroll
            for (int n = 0; n < 2; ++n) gv[bj][n] = *(const f32x4*)(gate + (size_t)b * MODW + col0 + bj * HALF + 4 * n) * coef;
#pragma unroll
        for (int ah = 0; ah < 4; ++ah) { const int ai = ah >> 1, m0 = (ah & 1) * 2;
            f32x4 h[2][2][2];
            if (in_bf16) {
                u32x4 hb[2][2];
#pragma unroll
                for (int mm = 0; mm < 2; ++mm) { const size_t off = (size_t)(row0 + ai * HALF + (m0 + mm) * 16) * D + col0;
#pragma unroll
                    for (int bj = 0; bj < 2; ++bj) hb[mm][bj] = *(const u32x4*)((const bf16*)Hin + off + bj * HALF); }
                asm volatile("" ::: "memory");
#pragma unroll
                for (int mm = 0; mm < 2; ++mm)
#pragma unroll
                    for (int bj = 0; bj < 2; ++bj) { const u32x4 w = hb[mm][bj];
                        h[mm][bj][0] = (f32x4){bf_lo(w.x), bf_hi(w.x), bf_lo(w.y), bf_hi(w.y)}; h[mm][bj][1] = (f32x4){bf_lo(w.z), bf_hi(w.z), bf_lo(w.w), bf_hi(w.w)}; }
            } else {
#pragma unroll
                for (int mm = 0; mm < 2; ++mm) { const size_t off = (size_t)(row0 + ai * HALF + (m0 + mm) * 16) * D + col0;
#pragma unroll
                    for (int bj = 0; bj < 2; ++bj)
#pragma unroll
                        for (int n = 0; n < 2; ++n) h[mm][bj][n] = *(const f32x4*)((const float*)Hin + off + bj * HALF + 4 * n); }
                asm volatile("" ::: "memory");
            }
#pragma unroll
            for (int mm = 0; mm < 2; ++mm) { const size_t off = (size_t)(row0 + ai * HALF + (m0 + mm) * 16) * D + col0;
#pragma unroll
                for (int bj = 0; bj < 2; ++bj) {
                    const f32x4 o0 = h[mm][bj][0] + gv[bj][0] * acc[ai][bj][m0 + mm][0], o1 = h[mm][bj][1] + gv[bj][1] * acc[ai][bj][m0 + mm][1];
                    if (out_bf16) { u32x4 w; w.x = cvt_pk_bf16(o0[0], o0[1]); w.y = cvt_pk_bf16(o0[2], o0[3]); w.z = cvt_pk_bf16(o1[0], o1[1]); w.w = cvt_pk_bf16(o1[2], o1[3]);
                        *(u32x4*)((bf16*)Hout + off + bj * HALF) = w; }
                    else { *(f32x4*)((float*)Hout + off + bj * HALF) = o0; *(f32x4*)((float*)Hout + off + bj * HALF + 4) = o1; } } }
            asm volatile("" ::: "memory");
        }
    }
};
struct EpiProj {
    static constexpr bool PERM = true, HAS_MID = false;
    unsigned char* big; int grp; const float* rot;
    __device__ __forceinline__ void mid(Acc&, const Unit&, int, int, int, int, int) const {}
    __device__ __forceinline__ void operator()(const Acc& acc, const Unit& u, int wr, int wc, int fr, int fq) const {
        int mode, plane, colt, ldc = D; float sc = 1.f; const int pn = u.pn;
        if (grp == 0) { plane = pn >> 2; colt = (pn & 3) * 256; mode = plane < 2 ? 1 : (plane == 2 ? 0 : 2); sc = plane == 1 ? 0.0625f : 1.f; }
        else if (grp == 1) {
            if (pn < 4) { plane = 0; colt = 256 * pn; mode = 0; }
            else if (pn < 12) { plane = 1; colt = 128 * (pn - 4); mode = 4; }
            else if (pn < 16) { plane = 2; colt = 256 * (pn - 12); mode = 0; sc = 0.125f; }
            else { plane = 3; colt = 0; mode = 0; ldc = 256; }
        } else { plane = pn >> 2; colt = (pn & 3) * 256; mode = 3; }
        bf16* O = (grp == 0 && plane == 3) ? (bf16*)(big + 208 * MiB) : (bf16*)(big + (size_t)plane * PLANE);
        const int row0 = u.pm * BM + wr * 64 + fr, cl = wc * 32 + 8 * fq;
        if (mode == 4) {
#pragma unroll
            for (int ai = 0; ai < 2; ++ai)
#pragma unroll
                for (int m = 0; m < 4; ++m) {
                    const f32x4 v0 = acc[ai][0][m][0] * acc[ai][1][m][0], v1 = acc[ai][0][m][1] * acc[ai][1][m][1];
                    u32x4 w; w.x = cvt_pk_bf16(v0[0], v0[1]); w.y = cvt_pk_bf16(v0[2], v0[3]); w.z = cvt_pk_bf16(v1[0], v1[1]); w.w = cvt_pk_bf16(v1[2], v1[3]);
                    *(u32x4*)(O + (size_t)(row0 + ai * HALF + m * 16) * D + colt + cl) = w;
                }
        } else if (mode == 1) {
#pragma unroll
            for (int ai = 0; ai < 2; ++ai) {
                f32x4 cs[4][4];
#pragma unroll
                for (int m = 0; m < 4; ++m) { const int pos = (row0 + ai * HALF + m * 16) & (SEQ - 1); const f32x4* rp = (const f32x4*)(rot + ((size_t)pos * 128 + cl) * 2);
#pragma unroll
                    for (int q = 0; q < 4; ++q) cs[m][q] = rp[q]; }
                asm volatile("" ::: "memory");
#pragma unroll
                for (int m = 0; m < 4; ++m) {
                    const int row = row0 + ai * HALF + m * 16;
                    const f32x4 c0 = cs[m][0], c1 = cs[m][1], c2 = cs[m][2], c3 = cs[m][3];
                    const f32x4 t1a = acc[ai][0][m][0], t1b = acc[ai][0][m][1], t2a = acc[ai][1][m][0], t2b = acc[ai][1][m][1];
                    u32x4 w1, w2;
                    w1.x = cvt_pk_bf16((t1a[0] * c0[0] - t2a[0] * c0[1]) * sc, (t1a[1] * c0[2] - t2a[1] * c0[3]) * sc);
                    w1.y = cvt_pk_bf16((t1a[2] * c1[0] - t2a[2] * c1[1]) * sc, (t1a[3] * c1[2] - t2a[3] * c1[3]) * sc);
                    w1.z = cvt_pk_bf16((t1b[0] * c2[0] - t2b[0] * c2[1]) * sc, (t1b[1] * c2[2] - t2b[1] * c2[3]) * sc);
                    w1.w = cvt_pk_bf16((t1b[2] * c3[0] - t2b[2] * c3[1]) * sc, (t1b[3] * c3[2] - t2b[3] * c3[3]) * sc);
                    w2.x = cvt_pk_bf16((t2a[0] * c0[0] + t1a[0] * c0[1]) * sc, (t2a[1] * c0[2] + t1a[1] * c0[3]) * sc);
                    w2.y = cvt_pk_bf16((t2a[2] * c1[0] + t1a[2] * c1[1]) * sc, (t2a[3] * c1[2] + t1a[3] * c1[3]) * sc);
                    w2.z = cvt_pk_bf16((t2b[0] * c2[0] + t1b[0] * c2[1]) * sc, (t2b[1] * c2[2] + t1b[1] * c2[3]) * sc);
                    w2.w = cvt_pk_bf16((t2b[2] * c3[0] + t1b[2] * c3[1]) * sc, (t2b[3] * c3[2] + t1b[3] * c3[3]) * sc);
                    bf16* rowp = O + (size_t)row * D + colt + cl;
                    *(u32x4*)rowp = w1; *(u32x4*)(rowp + HALF) = w2;
                }
                asm volatile("" ::: "memory");
            }
        } else {
#pragma unroll
            for (int ai = 0; ai < 2; ++ai)
#pragma unroll
                for (int m = 0; m < 4; ++m) {
                    bf16* rowp = O + (size_t)(row0 + ai * HALF + m * 16) * ldc + colt + cl;
#pragma unroll
                    for (int bj = 0; bj < 2; ++bj) {
                        f32x4 v0 = acc[ai][bj][m][0], v1 = acc[ai][bj][m][1];
                        if (mode == 0) { v0 = v0 * sc; v1 = v1 * sc; }
                        else if (mode == 2) {
#pragma unroll
                            for (int j = 0; j < 4; ++j) { v0[j] = silu_f(v0[j]); v1[j] = silu_f(v1[j]); } }
                        else {
#pragma unroll
                            for (int j = 0; j < 4; ++j) { v0[j] = sigmoid_f(v0[j]); v1[j] = sigmoid_f(v1[j]); } }
                        u32x4 w; w.x = cvt_pk_bf16(v0[0], v0[1]); w.y = cvt_pk_bf16(v0[2], v0[3]); w.z = cvt_pk_bf16(v1[0], v1[1]); w.w = cvt_pk_bf16(v1[2], v1[3]);
                        *(u32x4*)(rowp + bj * HALF) = w;
                    }
                }
        }
    }
};
struct EpiMerge {
    static constexpr bool PERM = true, HAS_MID = true;
    const bf16* gates;
    bf16* O;
    __device__ __forceinline__ void ld8(int plane, size_t off, f32x4& lo, f32x4& hi) const {
        const u32x4 w = *(const u32x4*)(gates + (size_t)plane * (PLANE / 2) + off);
        lo = (f32x4){bf_lo(w.x), bf_hi(w.x), bf_lo(w.y), bf_hi(w.y)}; hi = (f32x4){bf_lo(w.z), bf_hi(w.z), bf_lo(w.w), bf_hi(w.w)};
    }
    __device__ __forceinline__ u32x4 ldg(int plane, size_t off) const { return *(const u32x4*)(gates + (size_t)plane * (PLANE / 2) + off); }
    static __device__ __forceinline__ void unpack(const u32x4 w, f32x4& lo, f32x4& hi) {
        lo = (f32x4){bf_lo(w.x), bf_hi(w.x), bf_lo(w.y), bf_hi(w.y)}; hi = (f32x4){bf_lo(w.z), bf_hi(w.z), bf_lo(w.w), bf_hi(w.w)}; }
    __device__ __forceinline__ void mid(Acc& acc, const Unit& u, int which, int wr, int wc, int fr, int fq) const {
        const int pnum = which == 1 ? 1 : 2, pden = which == 1 ? 2 : 0;
        const int row0 = u.pm * BM + wr * 64 + fr, col0 = u.pn * BM + wc * 32 + 8 * fq;
#pragma unroll
        for (int ai = 0; ai < 2; ++ai) {
            u32x4 wn[4][2], wd[4][2];
#pragma unroll
            for (int m = 0; m < 4; ++m) { const size_t off = (size_t)(row0 + ai * HALF + m * 16) * D + col0;
#pragma unroll
                for (int bj = 0; bj < 2; ++bj) { wn[m][bj] = ldg(pnum, off + bj * HALF); wd[m][bj] = ldg(pden, off + bj * HALF); } }
            asm volatile("" ::: "memory");
#pragma unroll
            for (int m = 0; m < 4; ++m)
#pragma unroll
                for (int bj = 0; bj < 2; ++bj) {
                    f32x4 nl, nh, dl, dh; unpack(wn[m][bj], nl, nh); unpack(wd[m][bj], dl, dh);
#pragma unroll
                    for (int j = 0; j < 4; ++j) { acc[ai][bj][m][0][j] *= nl[j] * __builtin_amdgcn_rcpf(dl[j]); acc[ai][bj][m][1][j] *= nh[j] * __builtin_amdgcn_rcpf(dh[j]); }
                }
            asm volatile("" ::: "memory");
        }
    }
    __device__ __forceinline__ void operator()(const Acc& acc, const Unit& u, int wr, int wc, int fr, int fq) const {
        const int row0 = u.pm * BM + wr * 64 + fr, col0 = u.pn * BM + wc * 32 + 8 * fq;
#pragma unroll
        for (int ai = 0; ai < 2; ++ai) {
            u32x4 wg[4][2];
#pragma unroll
            for (int m = 0; m < 4; ++m) { const size_t off = (size_t)(row0 + ai * HALF + m * 16) * D + col0;
#pragma unroll
                for (int bj = 0; bj < 2; ++bj) wg[m][bj] = ldg(0, off + bj * HALF); }
            asm volatile("" ::: "memory");
#pragma unroll
            for (int m = 0; m < 4; ++m) { const size_t off = (size_t)(row0 + ai * HALF + m * 16) * D + col0;
#pragma unroll
                for (int bj = 0; bj < 2; ++bj) {
                    f32x4 gl, gh; unpack(wg[m][bj], gl, gh);
                    const f32x4 v0 = acc[ai][bj][m][0] * gl, v1 = acc[ai][bj][m][1] * gh;
                    u32x4 w; w.x = cvt_pk_bf16(v0[0], v0[1]); w.y = cvt_pk_bf16(v0[2], v0[3]); w.z = cvt_pk_bf16(v1[0], v1[1]); w.w = cvt_pk_bf16(v1[2], v1[3]);
                    *(u32x4*)(O + off + bj * HALF) = w;
                } }
            asm volatile("" ::: "memory");
        }
    }
};

template <class Epi>
__device__ __forceinline__ void gemm_phase(LAS unsigned char* lds, const Gemm g, const StaticOrder& S, const Epi& E, const int tid) {
    const int wid = __builtin_amdgcn_readfirstlane(tid >> 6), lane = tid & 63, wr = wid >> 2, wc = wid & 3, fr = lane & 15, fq = lane >> 4;
    const int K = g.K, nt = K / BK, lda = g.lda, segMask = (1 << g.segShift) - 1;
    unsigned voffA[2], voffB[2];
#pragma unroll
    for (int i = 0; i < 2; ++i) { int R, C; stage_rc(tid * 16 + i * 8192, R, C); const int Rb = Epi::PERM ? ((R & ~31) + perm32(R & 31)) : R;
        voffA[i] = (unsigned)(R * lda + C) * 2u; voffB[i] = (unsigned)(Rb * K + C) * 2u; }
    const size_t kstep = (size_t)(BK * 2);
    const size_t hstepA = (size_t)HALF * lda * 2, tstepA = 2 * hstepA;
    const size_t hstepB = (size_t)HALF * K * 2, tstepB = 2 * hstepB;
    const unsigned ldsw = (unsigned)wid * 1024u;
    const int aoff = lds_byte(wr * 64 + fr, fq * 8), boff = lds_byte(wc * 32 + fr, fq * 8);
#define PG8_KOFFA(t) ((size_t)((t) >> g.segShift) * g.segStride + (size_t)((t) & segMask) * kstep)
#define PG8_SA(b, h) (((b) * 2 + (h)) * HTB)
#define PG8_SB(b, h) ((4 + (b) * 2 + (h)) * HTB)
#define PG8_STAGE(bufoff, gbase, voff) do { _Pragma("unroll") for (int _i = 0; _i < 2; ++_i) \
        __builtin_amdgcn_global_load_lds((const unsigned*)((const char*)(gbase) + (voff)[_i]), (LAS unsigned*)(lds + (bufoff) + ldsw + _i * 8192), 16, 0, 0); } while (0)
#define PG8_LDA(dst, b, h) do { _Pragma("unroll") for (int m = 0; m < 4; ++m) _Pragma("unroll") for (int k = 0; k < 2; ++k) dst[m][k] = *(const LAS bf16x8*)(lds + PG8_SA(b, h) + aoff + m * 2048 + k * 1024); } while (0)
#define PG8_LDB(dst, b, h) do { _Pragma("unroll") for (int n = 0; n < 2; ++n) _Pragma("unroll") for (int k = 0; k < 2; ++k) dst[n][k] = *(const LAS bf16x8*)(lds + PG8_SB(b, h) + boff + n * 2048 + k * 1024); } while (0)
#define PG8_MMA(ai, bj, At, Bt) do { __builtin_amdgcn_s_setprio(1); _Pragma("unroll") for (int m = 0; m < 4; ++m) _Pragma("unroll") for (int n = 0; n < 2; ++n) _Pragma("unroll") for (int k = 0; k < 2; ++k) \
        acc[ai][bj][m][n] = __builtin_amdgcn_mfma_f32_16x16x32_bf16(Bt[n][k], At[m][k], acc[ai][bj][m][n], 0, 0, 0); __builtin_amdgcn_s_setprio(0); } while (0)
#define PG8_WAIT_V(n) asm volatile("s_waitcnt vmcnt(" #n ")" ::: "memory")
#define PG8_WAIT_L(n) asm volatile("s_waitcnt lgkmcnt(" #n ")" ::: "memory")
#define PG8_BAR __builtin_amdgcn_s_barrier()
#define PG8_SCHED __builtin_amdgcn_sched_barrier(0)
    Unit cur, nxt; int ui = 0;
    if (!S.next(0, cur)) return;
    Acc acc;
#pragma unroll
    for (int a = 0; a < 2; ++a)
#pragma unroll
        for (int b = 0; b < 2; ++b)
#pragma unroll
            for (int m = 0; m < 4; ++m)
#pragma unroll
                for (int n = 0; n < 2; ++n) acc[a][b][m][n] = (f32x4){0.f, 0.f, 0.f, 0.f};
    bf16x8 At[4][2], B0[2][2], B1[2][2];
    const char* cA = (const char*)g.A + (size_t)cur.pm * tstepA; const char* cB = (const char*)g.Bt + (size_t)cur.pn * tstepB;
    PG8_STAGE(PG8_SB(0, 0), cB, voffB); PG8_STAGE(PG8_SB(0, 1), cB + hstepB, voffB); PG8_STAGE(PG8_SA(0, 0), cA, voffA); PG8_STAGE(PG8_SA(0, 1), cA + hstepA, voffA);
    if (wr == 1) PG8_BAR;
    PG8_WAIT_V(2); PG8_BAR;
    PG8_STAGE(PG8_SB(1, 0), cB + kstep, voffB); PG8_STAGE(PG8_SA(1, 0), cA + kstep, voffA); PG8_STAGE(PG8_SB(1, 1), cB + hstepB + kstep, voffB);
    PG8_WAIT_V(6); PG8_BAR;
    for (;;) {
        const bool has_next = S.next(ui + 1, nxt);
        const char* nA = has_next ? (const char*)g.A + (size_t)nxt.pm * tstepA : cA; const char* nB = has_next ? (const char*)g.Bt + (size_t)nxt.pn * tstepB : cB;
        for (int t = 0; t < nt; t += 2) {
            const bool last = (t == nt - 2);
            const char* a1 = cA + PG8_KOFFA(t + 1);
            const char* a2 = last ? nA : cA + PG8_KOFFA(t + 2); const char* b2 = last ? nB : cB + (size_t)(t + 2) * kstep;
            const char* a3 = a2 + kstep; const char* b3 = b2 + kstep;
            PG8_LDB(B0, 0, 0); PG8_LDB(B1, 0, 1); PG8_SCHED; PG8_LDA(At, 0, 0); PG8_STAGE(PG8_SA(1, 1), a1 + hstepA, voffA);
            PG8_WAIT_V(8); PG8_WAIT_L(0); PG8_BAR; PG8_MMA(0, 0, At, B0); PG8_MMA(0, 1, At, B1); PG8_BAR; PG8_SCHED;
            PG8_LDA(At, 0, 1); PG8_STAGE(PG8_SB(0, 0), b2, voffB); PG8_STAGE(PG8_SB(0, 1), b2 + hstepB, voffB); PG8_STAGE(PG8_SA(0, 0), a2, voffA);
            PG8_WAIT_V(8); PG8_WAIT_L(0); PG8_BAR; PG8_MMA(1, 0, At, B0); PG8_MMA(1, 1, At, B1); PG8_BAR; PG8_SCHED;
            PG8_LDB(B0, 1, 0); PG8_LDB(B1, 1, 1); PG8_SCHED; PG8_LDA(At, 1, 0); PG8_STAGE(PG8_SA(0, 1), a2 + hstepA, voffA);
            PG8_WAIT_V(8); PG8_WAIT_L(0); PG8_BAR; PG8_MMA(0, 0, At, B0); PG8_MMA(0, 1, At, B1); PG8_BAR; PG8_SCHED;
            PG8_LDA(At, 1, 1); PG8_STAGE(PG8_SB(1, 0), b3, voffB); PG8_STAGE(PG8_SB(1, 1), b3 + hstepB, voffB); PG8_STAGE(PG8_SA(1, 0), a3, voffA);
            PG8_WAIT_V(8); PG8_WAIT_L(0); PG8_BAR; PG8_MMA(1, 0, At, B0); PG8_MMA(1, 1, At, B1); PG8_BAR; PG8_SCHED;
            if constexpr (Epi::HAS_MID) { if (!last && ((t + 2) & 15) == 0) { int fr_ = fr, fq_ = fq; asm volatile("" : "+v"(fr_), "+v"(fq_)); E.mid(acc, cur, (t + 2) >> 4, wr, wc, fr_, fq_); PG8_SCHED; } }
        }
        if (wr == 0) PG8_BAR;
        { int fr_ = fr, fq_ = fq; asm volatile("" : "+v"(fr_), "+v"(fq_)); E(acc, cur, wr, wc, fr_, fq_); }
        if (!has_next) break;
#pragma unroll
        for (int a = 0; a < 2; ++a)
#pragma unroll
            for (int b = 0; b < 2; ++b)
#pragma unroll
                for (int m = 0; m < 4; ++m)
#pragma unroll
                    for (int n = 0; n < 2; ++n) acc[a][b][m][n] = (f32x4){0.f, 0.f, 0.f, 0.f};
        cur = nxt; cA = nA; cB = nB; ++ui;
        if (wr == 1) PG8_BAR;
    }
    PG8_WAIT_V(0);
    PG8_BAR;
#undef PG8_KOFFA
#undef PG8_SA
#undef PG8_SB
#undef PG8_STAGE
#undef PG8_LDA
#undef PG8_LDB
#undef PG8_MMA
#undef PG8_WAIT_V
#undef PG8_WAIT_L
#undef PG8_BAR
#undef PG8_SCHED
}
}

__device__ __forceinline__ void transpose_item(const float* W, int N, int k0, int n0, bf16* WT, int Kd, int drow0, int dcol0, LAS float* scr, int lane) {
    float tv[32];
#pragma unroll
    for (int i = 0; i < 32; ++i) { const int kk = 2 * i + (lane >> 5); tv[i] = W[(size_t)(k0 + kk) * N + n0 + (lane & 31)]; }
#pragma unroll
    for (int i = 0; i < 32; ++i) { const int kk = 2 * i + (lane >> 5); scr[kk * 33 + (lane & 31)] = tv[i]; }
    if (0) for (int i = 0; i < 32; ++i) { const int kk = 2 * i + (lane >> 5); scr[kk * 33 + (lane & 31)] = W[(size_t)(k0 + kk) * N + n0 + (lane & 31)]; }
    LDS_WAIT();
    const int c = lane & 7;
#pragma unroll
    for (int j = 0; j < 4; ++j) { const int n = (lane >> 3) + 8 * j; const LAS float* s = scr + (8 * c) * 33 + n;
        u32x4 o; o.x = cvt_pk_bf16(s[0 * 33], s[1 * 33]); o.y = cvt_pk_bf16(s[2 * 33], s[3 * 33]); o.z = cvt_pk_bf16(s[4 * 33], s[5 * 33]); o.w = cvt_pk_bf16(s[6 * 33], s[7 * 33]);
        *(u32x4*)(WT + (size_t)(drow0 + n) * Kd + dcol0 + k0 + 8 * c) = o; }
    LDS_WAIT();
}
__device__ __forceinline__ void convert_ffn(const float* w1, const float* w3, const float* w2, unsigned char* ws, LAS float* scr, int gw, int ngw, int lane) {
    bf16* W13 = (bf16*)(ws + W_W13); bf16* W2 = (bf16*)(ws + W_W2);
    for (int it = gw; it < 4224; it += ngw) {
        if (it < 2816) { const int sel = it >= 1408, r = it - sel * 1408, kb = r / 88, nb = r % 88, n0 = 32 * nb;
            transpose_item(sel ? w3 : w1, DFF, 64 * kb, n0, W13, D, 256 * (n0 >> 7) + 128 * sel + (n0 & 127), 0, scr, lane); }
        else { const int r = it - 2816, kb = r / 32, nb = r % 32; transpose_item(w2, D, 64 * kb, 32 * nb, W2, DFF, 32 * nb, 0, scr, lane); }
    }
}
__device__ __forceinline__ void convert_mixer(const float* w_in, const float* p_ret, const float* p_conv, const float* p_swa, const float* w_out, unsigned char* ws, LAS float* scr, int gw, int ngw, int lane) {
    bf16* WIN = (bf16*)(ws + W_IN); bf16* PC = (bf16*)(ws + W_PCAT); bf16* WO = (bf16*)(ws + W_OUT);
    for (int it = gw; it < 7808; it += ngw) {
        if (it < 5760) { const int kb = it / 360, nb = it % 360, n0 = 32 * nb; int dr = n0;
            if (n0 >= 5120 && n0 < 6144) { const int ch = n0 - 5120; dr = 5120 + 256 * (ch >> 7) + (ch & 127); }
            else if (n0 >= 6144 && n0 < 7168) { const int ch = n0 - 6144; dr = 5120 + 256 * (ch >> 7) + 128 + (ch & 127); }
            transpose_item(w_in, INC, 64 * kb, n0, WIN, D, dr, 0, scr, lane); }
        else if (it < 7296) { const int r = it - 5760, sel = r / 512, q = r % 512, kb = q / 32, nb = q % 32;
            transpose_item(sel == 0 ? p_conv : (sel == 1 ? p_swa : p_ret), D, 64 * kb, 32 * nb, PC, 3 * D, 32 * nb, sel * D, scr, lane); }
        else { const int q = it - 7296, kb = q / 32, nb = q % 32; transpose_item(w_out, D, 64 * kb, 32 * nb, WO, D, 32 * nb, 0, scr, lane); }
    }
}
__device__ __forceinline__ void norm_rows(const void* hin, const int in_bf16, const float* gain, const float* sh, const float* sc, bf16* U, int gw, int ngw, int lane) {
    for (int blk = gw; blk < M / 16; blk += ngw) {
        const int r0 = blk * 16, b = r0 >> 12;
        f32x4 gm[4], sv[4];
#pragma unroll
        for (int j = 0; j < 4; ++j) { const int col = 4 * (64 * j + lane); const f32x4 g4 = *(const f32x4*)(gain + col), s4 = *(const f32x4*)(sc + (size_t)b * MODW + col);
            gm[j] = g4 * (s4 + 1.0f); sv[j] = *(const f32x4*)(sh + (size_t)b * MODW + col); }
        for (int r = r0; r < r0 + 16; r += 4) {
            f32x4 v[4][4]; float s[4];
#pragma unroll
            for (int q = 0; q < 4; ++q) {
                if (in_bf16) { const u32x2* xb = (const u32x2*)((const bf16*)hin + (size_t)(r + q) * D) + lane;
#pragma unroll
                    for (int j = 0; j < 4; ++j) { const u32x2 w = xb[64 * j]; v[q][j] = (f32x4){bf_lo(w.x), bf_hi(w.x), bf_lo(w.y), bf_hi(w.y)}; } }
                else { const f32x4* xr = (const f32x4*)((const float*)hin + (size_t)(r + q) * D) + lane;
#pragma unroll
                    for (int j = 0; j < 4; ++j) v[q][j] = xr[64 * j]; } }
#pragma unroll
            for (int q = 0; q < 4; ++q) { s[q] = 0.f;
#pragma unroll
                for (int j = 0; j < 4; ++j) s[q] += (v[q][j][0] * v[q][j][0] + v[q][j][1] * v[q][j][1]) + (v[q][j][2] * v[q][j][2] + v[q][j][3] * v[q][j][3]); }
#pragma unroll
            for (int o = 1; o < 64; o <<= 1) {
#pragma unroll
                for (int q = 0; q < 4; ++q) s[q] += __shfl_xor(s[q], o); }
#pragma unroll
            for (int q = 0; q < 4; ++q) { const float rstd = 1.0f / sqrtf(s[q] * (1.0f / D) + EPS);
                u32x2* o8 = (u32x2*)(U + (size_t)(r + q) * D) + lane;
#pragma unroll
                for (int j = 0; j < 4; ++j) { const f32x4 y = v[q][j] * rstd * gm[j] + sv[j]; u32x2 w; w.x = cvt_pk_bf16(y[0], y[1]); w.y = cvt_pk_bf16(y[2], y[3]); o8[64 * j] = w; } }
        }
    }
}
__device__ __forceinline__ void final_norm_rows(const float* h, float* outp, const float* gain, int gw, int ngw, int lane) {
    f32x4 gm[4];
#pragma unroll
    for (int j = 0; j < 4; ++j) gm[j] = *(const f32x4*)(gain + 4 * (64 * j + lane));
    for (int r0 = gw * 4; r0 < M; r0 += ngw * 4) {
        f32x4 v[4][4]; float s[4];
#pragma unroll
        for (int q = 0; q < 4; ++q) { const f32x4* xr = (const f32x4*)(h + (size_t)(r0 + q) * D) + lane;
#pragma unroll
            for (int j = 0; j < 4; ++j) v[q][j] = xr[64 * j]; }
#pragma unroll
        for (int q = 0; q < 4; ++q) { s[q] = 0.f;
#pragma unroll
            for (int j = 0; j < 4; ++j) s[q] += (v[q][j][0] * v[q][j][0] + v[q][j][1] * v[q][j][1]) + (v[q][j][2] * v[q][j][2] + v[q][j][3] * v[q][j][3]); }
#pragma unroll
        for (int o = 1; o < 64; o <<= 1) {
#pragma unroll
            for (int q = 0; q < 4; ++q) s[q] += __shfl_xor(s[q], o); }
#pragma unroll
        for (int q = 0; q < 4; ++q) { const float rstd = 1.0f / sqrtf(s[q] * (1.0f / D) + EPS); f32x4* xw = (f32x4*)(outp + (size_t)(r0 + q) * D) + lane;
#pragma unroll
            for (int j = 0; j < 4; ++j) xw[64 * j] = v[q][j] * rstd * gm[j]; }
    }
}
__device__ __forceinline__ void p0_phase(LAS unsigned char* lds, const float* c, const float* ada_w, const float* ada_b, unsigned char* ws, int vcu, int G, int tid, int lane, int wave) {
    LAS float* cact = (LAS float*)lds; LAS float* red = (LAS float*)(lds + 32768);
    for (int i = tid; i < BATCH * D; i += 512) cact[i] = silu_f(c[i]);
    WG_BAR();
    float* mod = (float*)(ws + WS_MOD);
    for (int item = vcu; item < 288; item += G) {
        const int l = item / 144, cb = item % 144;
        const float* W = ada_w + (size_t)l * D * MODW + 64 * cb + lane;
        float a[8];
#pragma unroll
        for (int b = 0; b < 8; ++b) a[b] = 0.f;
#pragma unroll 16
        for (int k = 128 * wave; k < 128 * wave + 128; ++k) { const float w = W[(size_t)k * MODW];
#pragma unroll
            for (int b = 0; b < 8; ++b) a[b] += cact[b * D + k] * w; }
#pragma unroll
        for (int b = 0; b < 8; ++b) red[(wave * 8 + b) * 64 + lane] = a[b];
        WG_BAR();
        { const int b = wave; float s = ada_b[(size_t)l * MODW + 64 * cb + lane];
#pragma unroll
            for (int wv = 0; wv < 8; ++wv) s += red[(wv * 8 + b) * 64 + lane];
            mod[((size_t)l * 8 + b) * MODW + 64 * cb + lane] = s; }
        WG_BAR();
    }
    f32x2* rot = (f32x2*)(ws + WS_ROT);
    for (int e = vcu * 512 + tid; e < SEQ * 128; e += G * 512) {
        const int pos = e >> 7, j = e & 127;
        const float lin = (float)j / 127.0f;
        const float inv = exp2f(-lin * 13.287712379549449f);
        const float ang = (float)pos * inv;
        float sn, cs; sincosf(ang, &sn, &cs);
        rot[e] = (f32x2){cs, sn};
    }
}

__device__ __forceinline__ void scan_phase(LAS unsigned char* lds, const bf16* RQ, const bf16* RK, const bf16* RV, bf16* RO, float* ssq, int vcu, int tid, int lane, int wave, const int pmode = 0) {
    constexpr int KROW = 528, VROW = 80, SROW = 528;
    LAS unsigned char* Ks = lds; LAS unsigned char* Vs = lds + 67584; LAS unsigned char* Vzs = Vs + 10240; LAS unsigned char* Ss0 = Vzs + 10240; LAS unsigned char* Ss1 = Ss0 + 16896;
    const int p = vcu >> 3, s = vcu & 7, b = p >> 2, h = p & 3;
    const int g = lane >> 4, c16 = lane & 15, q4 = (lane >> 2) & 3, p4 = lane & 3;
    const float lg = log2f(1.0f - exp2f(-5.0f - (float)h));
    const size_t tokbase = (size_t)b * SEQ;
    for (int i = tid; i < 16896 / 4; i += 512) ((LAS unsigned*)Ss0)[i] = 0u;
    f32x4 accS[2][2];
#pragma unroll
    for (int a = 0; a < 2; ++a)
#pragma unroll
        for (int c = 0; c < 2; ++c) accS[a][c] = (f32x4){0.f, 0.f, 0.f, 0.f};
    u32x4 kreg[8]; u32x4 vreg; bf16x8 qn[8];
    const int vrow = tid >> 2, vc16 = tid & 3;
#define SCAN_LOAD(n) do { const size_t t0_ = tokbase + (size_t)(n) * 128; \
        _Pragma("unroll") for (int i_ = 0; i_ < 8; ++i_) { const int c_ = tid + 512 * i_; kreg[i_] = *(const u32x4*)(RK + (t0_ + (c_ >> 5)) * D + 256 * h + (c_ & 31) * 8); } \
        vreg = *(const u32x4*)(RV + (t0_ + vrow) * D + 256 * h + 32 * s + vc16 * 8); \
        _Pragma("unroll") for (int ks_ = 0; ks_ < 8; ++ks_) qn[ks_] = *(const bf16x8*)(RQ + (t0_ + 16 * wave + c16) * D + 256 * h + 32 * ks_ + 8 * g); } while (0)
    SCAN_LOAD(0);
    int cur = 0;
    for (int n = 0; n < 32; ++n) {
        WG_BAR();
#pragma unroll
        for (int i = 0; i < 8; ++i) { const int c = tid + 512 * i; *(LAS u32x4*)(Ks + (c >> 5) * KROW + (c & 31) * 16) = kreg[i]; }
        *(LAS u32x4*)(Vs + vrow * VROW + vc16 * 16) = vreg;
        { const float z = exp2f(lg * (float)(127 - vrow)); u32x4 w;
            w.x = cvt_pk_bf16(bf_lo(vreg.x) * z, bf_hi(vreg.x) * z); w.y = cvt_pk_bf16(bf_lo(vreg.y) * z, bf_hi(vreg.y) * z);
            w.z = cvt_pk_bf16(bf_lo(vreg.z) * z, bf_hi(vreg.z) * z); w.w = cvt_pk_bf16(bf_lo(vreg.w) * z, bf_hi(vreg.w) * z);
            *(LAS u32x4*)(Vzs + vrow * VROW + vc16 * 16) = w; }
        bf16x8 qc[8];
#pragma unroll
        for (int ks = 0; ks < 8; ++ks) qc[ks] = qn[ks];
        const size_t tok0 = tokbase + (size_t)n * 128;
        if (n + 1 < 32 && !(pmode & 1)) SCAN_LOAD(n + 1);
        WG_BAR();
        LAS unsigned char* Sc = cur ? Ss1 : Ss0; LAS unsigned char* Sn = cur ? Ss0 : Ss1;
        const int i_loc = 16 * wave + c16;
        f32x4 accX[2], accI[2];
#pragma unroll
        for (int mt = 0; mt < 2; ++mt) { accX[mt] = (f32x4){0.f, 0.f, 0.f, 0.f}; accI[mt] = (f32x4){0.f, 0.f, 0.f, 0.f}; }
        {
#pragma unroll
            for (int kh = 0; kh < 4; ++kh) {
                bf16x8 fa[4];
#pragma unroll
                for (int k4 = 0; k4 < 2; ++k4)
#pragma unroll
                    for (int mt = 0; mt < 2; ++mt) fa[2 * k4 + mt] = *(const LAS bf16x8*)(Sc + (16 * mt + c16) * SROW + (32 * (2 * kh + k4) + 8 * g) * 2);
                asm volatile("" ::: "memory");
#pragma unroll
                for (int k4 = 0; k4 < 2; ++k4)
#pragma unroll
                    for (int mt = 0; mt < 2; ++mt) accX[mt] = mfma16(fa[2 * k4 + mt], qc[2 * kh + k4], accX[mt]);
            }
        }
        const int nkb = (pmode & 2) ? 0 : (wave >> 1) + 1;
        for (int kb = 0; kb < nkb; ++kb) {
            f32x4 st[2]; s16x4 vlo[2], vhi[2];
#pragma unroll
            for (int t = 0; t < 2; ++t) st[t] = (f32x4){0.f, 0.f, 0.f, 0.f};
#pragma unroll
            for (int kh = 0; kh < 4; ++kh) {
                bf16x8 fk[4];
#pragma unroll
                for (int k4 = 0; k4 < 2; ++k4)
#pragma unroll
                    for (int t = 0; t < 2; ++t) fk[2 * k4 + t] = *(const LAS bf16x8*)(Ks + (16 * (2 * kb + t) + c16) * KROW + (32 * (2 * kh + k4) + 8 * g) * 2);
                asm volatile("" ::: "memory");
#pragma unroll
                for (int k4 = 0; k4 < 2; ++k4)
#pragma unroll
                    for (int t = 0; t < 2; ++t) st[t] = mfma16(fk[2 * k4 + t], qc[2 * kh + k4], st[t]);
            }
            float pv[2][4];
#pragma unroll
            for (int t = 0; t < 2; ++t)
#pragma unroll
                for (int r = 0; r < 4; ++r) { const int d = i_loc - (16 * (2 * kb + t) + 4 * g + r); pv[t][r] = d >= 0 ? st[t][r] * __builtin_amdgcn_exp2f(lg * (float)d) : 0.f; }
            u32x4 pw; pw.x = cvt_pk_bf16(pv[0][0], pv[0][1]); pw.y = cvt_pk_bf16(pv[0][2], pv[0][3]); pw.z = cvt_pk_bf16(pv[1][0], pv[1][1]); pw.w = cvt_pk_bf16(pv[1][2], pv[1][3]);
            const bf16x8 pb = __builtin_bit_cast(bf16x8, pw);
#pragma unroll
            for (int mt = 0; mt < 2; ++mt) { vlo[mt] = tr_read(Vs + (32 * kb + 4 * g + q4) * VROW + (16 * mt + 4 * p4) * 2); vhi[mt] = tr_read(Vs + (32 * kb + 16 + 4 * g + q4) * VROW + (16 * mt + 4 * p4) * 2); }
#pragma unroll
            for (int mt = 0; mt < 2; ++mt) accI[mt] = mfma16(cat4(vlo[mt], vhi[mt]), pb, accI[mt]);
        }
        {
            const float xi = exp2f(lg * (float)(i_loc + 1)); float ss = 0.f;
#pragma unroll
            for (int mt = 0; mt < 2; ++mt) { const f32x4 o = accI[mt] + accX[mt] * xi; ss += (o[0] * o[0] + o[1] * o[1]) + (o[2] * o[2] + o[3] * o[3]);
                u32x2 w; w.x = cvt_pk_bf16(o[0], o[1]); w.y = cvt_pk_bf16(o[2], o[3]);
                *(u32x2*)(RO + (tok0 + i_loc) * D + 256 * h + 32 * s + 16 * mt + 4 * g) = w; }
            ss += __shfl_xor(ss, 16); ss += __shfl_xor(ss, 32);
            if (g == 0 && pmode == 0) ssq[((tok0 + i_loc) * 4 + h) * 8 + s] = ss;
        }
        {
            const float decay = exp2f(lg * 128.0f);
#pragma unroll
            for (int mt = 0; mt < 2; ++mt)
#pragma unroll
                for (int nt = 0; nt < 2; ++nt) accS[mt][nt] = accS[mt][nt] * decay;
#pragma unroll
            for (int k4 = 0; k4 < 4; ++k4) {
                bf16x8 Af[2], Bf[2];
#pragma unroll
                for (int mt = 0; mt < 2; ++mt) Af[mt] = cat4(tr_read(Vzs + (32 * k4 + 8 * g + q4) * VROW + (16 * mt + 4 * p4) * 2), tr_read(Vzs + (32 * k4 + 8 * g + 4 + q4) * VROW + (16 * mt + 4 * p4) * 2));
#pragma unroll
                for (int nt = 0; nt < 2; ++nt) Bf[nt] = cat4(tr_read(Ks + (32 * k4 + 8 * g + q4) * KROW + (32 * wave + 16 * nt + 4 * p4) * 2), tr_read(Ks + (32 * k4 + 8 * g + 4 + q4) * KROW + (32 * wave + 16 * nt + 4 * p4) * 2));
#pragma unroll
                for (int mt = 0; mt < 2; ++mt)
#pragma unroll
                    for (int nt = 0; nt < 2; ++nt) accS[mt][nt] = mfma16(Af[mt], Bf[nt], accS[mt][nt]);
            }
#pragma unroll
            for (int mt = 0; mt < 2; ++mt)
#pragma unroll
                for (int nt = 0; nt < 2; ++nt)
#pragma unroll
                    for (int r = 0; r < 4; ++r) *(LAS bf16*)(Sn + (16 * mt + 4 * g + r) * SROW + (32 * wave + 16 * nt + c16) * 2) = (bf16)(cvt_pk_bf16(accS[mt][nt][r], 0.f) & 0xffffu);
        }
        cur ^= 1;
    }
#undef SCAN_LOAD
    WG_BAR();
}

struct ConvRegs { u32x4 z0[2], z1[2], z2[2], cb[2]; };
__device__ __forceinline__ void conv_load(const bf16* CB, const bf16* Z, int idx, int nthr, int c8, ConvRegs& r) {
#pragma unroll
    for (int u = 0; u < 2; ++u) { const int t = (idx + u * nthr) >> 7, pos = t & (SEQ - 1);
        r.z0[u] = *(const u32x4*)(Z + (size_t)t * D + 8 * c8);
        r.z1[u] = (u32x4){0u, 0u, 0u, 0u}; r.z2[u] = (u32x4){0u, 0u, 0u, 0u};
        if (pos >= 1) r.z1[u] = *(const u32x4*)(Z + (size_t)(t - 1) * D + 8 * c8);
        if (pos >= 2) r.z2[u] = *(const u32x4*)(Z + (size_t)(t - 2) * D + 8 * c8);
        r.cb[u] = *(const u32x4*)(CB + (size_t)t * D + 8 * c8); }
}
__device__ __forceinline__ void conv_finish(bf16* Yb, const f32x4 (&cwv)[6], int idx, int nthr, int c8, const ConvRegs& r) {
#pragma unroll
    for (int u = 0; u < 2; ++u) { const int t = (idx + u * nthr) >> 7;
        float y[8];
        const unsigned zz0[4] = {r.z0[u].x, r.z0[u].y, r.z0[u].z, r.z0[u].w}, zz1[4] = {r.z1[u].x, r.z1[u].y, r.z1[u].z, r.z1[u].w}, zz2[4] = {r.z2[u].x, r.z2[u].y, r.z2[u].z, r.z2[u].w}, cc[4] = {r.cb[u].x, r.cb[u].y, r.cb[u].z, r.cb[u].w};
#pragma unroll
        for (int k = 0; k < 4; ++k) {
            const float wa0 = k < 2 ? cwv[0][2 * k] : cwv[1][2 * k - 4], wb0 = k < 2 ? cwv[0][2 * k + 1] : cwv[1][2 * k - 3];
            const float wa1 = k < 2 ? cwv[2][2 * k] : cwv[3][2 * k - 4], wb1 = k < 2 ? cwv[2][2 * k + 1] : cwv[3][2 * k - 3];
            const float wa2 = k < 2 ? cwv[4][2 * k] : cwv[5][2 * k - 4], wb2 = k < 2 ? cwv[4][2 * k + 1] : cwv[5][2 * k - 3];
            y[2 * k] = bf_lo(cc[k]) * (wa0 * bf_lo(zz2[k]) + wa1 * bf_lo(zz1[k]) + wa2 * bf_lo(zz0[k]));
            y[2 * k + 1] = bf_hi(cc[k]) * (wb0 * bf_hi(zz2[k]) + wb1 * bf_hi(zz1[k]) + wb2 * bf_hi(zz0[k]));
        }
        u32x4 w; w.x = cvt_pk_bf16(y[0], y[1]); w.y = cvt_pk_bf16(y[2], y[3]); w.z = cvt_pk_bf16(y[4], y[5]); w.w = cvt_pk_bf16(y[6], y[7]);
        *(u32x4*)(Yb + (size_t)t * D + 8 * c8) = w; }
}
__device__ __forceinline__ void swa_phase(LAS unsigned char* lds, const bf16* SQ, const bf16* SKV, bf16* Yc, const float* sinks, int vcu, int G, int tid, int lane, int wave,
                                          const bool fuse, const bf16* CB, const bf16* Z, const float* cw, bf16* Yb, int gtid, int nthr) {
    const int cc8 = gtid & 127; int cit = 0;
    f32x4 cwv[6];
#pragma unroll
    for (int j = 0; j < 3; ++j) { cwv[2 * j] = *(const f32x4*)(cw + j * D + 8 * cc8); cwv[2 * j + 1] = *(const f32x4*)(cw + j * D + 8 * cc8 + 4); }
    constexpr int ROWB = 144;
    LAS unsigned char* Ks = lds; LAS unsigned char* Vs = lds + 256 * ROWB;
    const int g = lane >> 4, c16 = lane & 15, q4 = (lane >> 2) & 3, p4 = lane & 3;
    for (int unit = vcu; unit < 512; unit += G) {
        const int b = unit >> 6, nb = (unit >> 1) & 31, kvh = unit & 1;
        const size_t tok_cur = (size_t)b * SEQ + 128 * nb, tok_prev = nb > 0 ? tok_cur - 128 : tok_cur;
        const bf16* qsrc = SQ + (tok_cur + 16 * wave + c16) * D + 64 * (8 * kvh) + 8 * g;
        bf16x8 qn0 = *(const bf16x8*)(qsrc), qn1 = *(const bf16x8*)(qsrc + 32);
        u32x4 kr[4], vr[4];
        { const int row = tid >> 1, half = tid & 1; const size_t tok = row < 128 ? tok_prev + row : tok_cur + (row - 128);
            const bf16* src = SKV + tok * 256 + 64 * kvh + 32 * half;
#pragma unroll
            for (int i = 0; i < 4; ++i) { kr[i] = *(const u32x4*)(src + 8 * i); vr[i] = *(const u32x4*)(src + 128 + 8 * i); }
            WG_BAR();
#pragma unroll
            for (int i = 0; i < 4; ++i) { *(LAS u32x4*)(Ks + row * ROWB + half * 64 + 16 * i) = kr[i]; *(LAS u32x4*)(Vs + row * ROWB + half * 64 + 16 * i) = vr[i]; }
        }
        WG_BAR();
        const int jt0 = 2 * (wave >> 1), iq = 16 * wave + c16;
        for (int hq = 0; hq < 8; ++hq) {
            const float sink = sinks[8 * kvh + hq];
            const bf16x8 q0 = qn0, q1 = qn1;
            int iqm = iq; asm volatile("" : "+v"(iqm));
            ConvRegs cr; const bool doconv = fuse && cit < 16;
            if (doconv) conv_load(CB, Z, gtid + cit * 2 * nthr, nthr, cc8, cr);
            if (hq < 7) { qn0 = *(const bf16x8*)(qsrc + 64 * (hq + 1)); qn1 = *(const bf16x8*)(qsrc + 64 * (hq + 1) + 32); }
            f32x4 st[10];
#pragma unroll
            for (int hf = 0; hf < 2; ++hf) {
                bf16x8 fk[10];
#pragma unroll
                for (int t = 0; t < 5; ++t)
#pragma unroll
                    for (int ks = 0; ks < 2; ++ks) fk[2 * t + ks] = *(const LAS bf16x8*)(Ks + (16 * (jt0 + 5 * hf + t) + c16) * ROWB + (32 * ks + 8 * g) * 2);
                asm volatile("" ::: "memory");
#pragma unroll
                for (int t = 0; t < 5; ++t) { st[5 * hf + t] = mfma16(fk[2 * t], q0, (f32x4){0.f, 0.f, 0.f, 0.f}); st[5 * hf + t] = mfma16(fk[2 * t + 1], q1, st[5 * hf + t]); }
            }
            float mx = sink;
#pragma unroll
            for (int t = 0; t < 10; ++t)
#pragma unroll
                for (int r = 0; r < 4; ++r) { const int j = 16 * (jt0 + t) + 4 * g + r, d = iqm + 128 - j; const bool valid = (d >= 0) && (d < 128) && (nb > 0 || j >= 128);
                    st[t][r] = valid ? st[t][r] : -INFINITY; mx = fmaxf(mx, st[t][r]); }
            mx = fmaxf(mx, __shfl_xor(mx, 16)); mx = fmaxf(mx, __shfl_xor(mx, 32));
            float sum = 0.f;
#pragma unroll
            for (int t = 0; t < 10; ++t)
#pragma unroll
                for (int r = 0; r < 4; ++r) { st[t][r] = __builtin_amdgcn_exp2f((st[t][r] - mx) * LOG2E); sum += st[t][r]; }
            sum += __shfl_xor(sum, 16); sum += __shfl_xor(sum, 32);
            const float inv = 1.0f / (sum + __builtin_amdgcn_exp2f((sink - mx) * LOG2E));
            f32x4 o[4];
#pragma unroll
            for (int dt = 0; dt < 4; ++dt) o[dt] = (f32x4){0.f, 0.f, 0.f, 0.f};
#pragma unroll
            for (int kbi = 0; kbi < 5; ++kbi) {
                u32x4 pw; pw.x = cvt_pk_bf16(st[2 * kbi][0], st[2 * kbi][1]); pw.y = cvt_pk_bf16(st[2 * kbi][2], st[2 * kbi][3]);
                pw.z = cvt_pk_bf16(st[2 * kbi + 1][0], st[2 * kbi + 1][1]); pw.w = cvt_pk_bf16(st[2 * kbi + 1][2], st[2 * kbi + 1][3]);
                const bf16x8 pb = __builtin_bit_cast(bf16x8, pw);
                s16x4 lo[4], hi[4];
#pragma unroll
                for (int dt = 0; dt < 4; ++dt) { lo[dt] = tr_read(Vs + (16 * (jt0 + 2 * kbi) + 4 * g + q4) * ROWB + (16 * dt + 4 * p4) * 2); hi[dt] = tr_read(Vs + (16 * (jt0 + 2 * kbi + 1) + 4 * g + q4) * ROWB + (16 * dt + 4 * p4) * 2); }
                asm volatile("" ::: "memory");
#pragma unroll
                for (int dt = 0; dt < 4; ++dt) o[dt] = mfma16(cat4(lo[dt], hi[dt]), pb, o[dt]);
            }
#pragma unroll
            for (int dt = 0; dt < 4; ++dt) { u32x2 w; w.x = cvt_pk_bf16(o[dt][0] * inv, o[dt][1] * inv); w.y = cvt_pk_bf16(o[dt][2] * inv, o[dt][3] * inv);
                *(u32x2*)(Yc + (tok_cur + iq) * D + 64 * (8 * kvh + hq) + 16 * dt + 4 * g) = w; }
            if (doconv) conv_finish(Yb, cwv, gtid + cit * 2 * nthr, nthr, cc8, cr);
            ++cit;
        }
    }
    WG_BAR();
}
__device__ __forceinline__ void ya_pass(const bf16* R, const bf16* RG, const float* ssq, bf16* Ya, int gtid, int nthr) {
    for (int idx = gtid; idx < M * 128; idx += 2 * nthr) {
        u32x4 r[2], gq[2]; f32x4 s0[2], s1[2];
#pragma unroll
        for (int u = 0; u < 2; ++u) { const int i = idx + u * nthr, t = i >> 7, c8 = i & 127, h = c8 >> 5;
            const f32x4* sp = (const f32x4*)(ssq + ((size_t)t * 4 + h) * 8); s0[u] = sp[0]; s1[u] = sp[1];
            r[u] = *(const u32x4*)(R + (size_t)t * D + 8 * c8); gq[u] = *(const u32x4*)(RG + (size_t)t * D + 8 * c8); }
#pragma unroll
        for (int u = 0; u < 2; ++u) { const int i = idx + u * nthr, t = i >> 7, c8 = i & 127;
            const float tot = ((s0[u][0] + s0[u][1]) + (s0[u][2] + s0[u][3])) + ((s1[u][0] + s1[u][1]) + (s1[u][2] + s1[u][3]));
            const float rstd = 1.0f / sqrtf(tot * (1.0f / 256.0f) + EPS);
            u32x4 w;
            w.x = cvt_pk_bf16(bf_lo(gq[u].x) * (bf_lo(r[u].x) * rstd), bf_hi(gq[u].x) * (bf_hi(r[u].x) * rstd)); w.y = cvt_pk_bf16(bf_lo(gq[u].y) * (bf_lo(r[u].y) * rstd), bf_hi(gq[u].y) * (bf_hi(r[u].y) * rstd));
            w.z = cvt_pk_bf16(bf_lo(gq[u].z) * (bf_lo(r[u].z) * rstd), bf_hi(gq[u].z) * (bf_hi(r[u].z) * rstd)); w.w = cvt_pk_bf16(bf_lo(gq[u].w) * (bf_lo(r[u].w) * rstd), bf_hi(gq[u].w) * (bf_hi(r[u].w) * rstd));
            *(u32x4*)(Ya + (size_t)t * D + 8 * c8) = w; }
    }
}
__device__ __forceinline__ void conv_pass(const bf16* CB, const bf16* Z, const float* cw, bf16* Yb, int gtid, int nthr) {
    const int c8 = gtid & 127;
    const f32x4 w0a = *(const f32x4*)(cw + 8 * c8), w0b = *(const f32x4*)(cw + 8 * c8 + 4), w1a = *(const f32x4*)(cw + D + 8 * c8), w1b = *(const f32x4*)(cw + D + 8 * c8 + 4),
                w2a = *(const f32x4*)(cw + 2 * D + 8 * c8), w2b = *(const f32x4*)(cw + 2 * D + 8 * c8 + 4);
    for (int idx = gtid; idx < M * 128; idx += 2 * nthr) {
        u32x4 z0[2], z1[2], z2[2], cbv[2];
#pragma unroll
        for (int u = 0; u < 2; ++u) { const int t = (idx + u * nthr) >> 7, pos = t & (SEQ - 1);
            z0[u] = *(const u32x4*)(Z + (size_t)t * D + 8 * c8);
            z1[u] = (u32x4){0u, 0u, 0u, 0u}; z2[u] = (u32x4){0u, 0u, 0u, 0u};
            if (pos >= 1) z1[u] = *(const u32x4*)(Z + (size_t)(t - 1) * D + 8 * c8);
            if (pos >= 2) z2[u] = *(const u32x4*)(Z + (size_t)(t - 2) * D + 8 * c8);
            cbv[u] = *(const u32x4*)(CB + (size_t)t * D + 8 * c8); }
#pragma unroll
        for (int u = 0; u < 2; ++u) { const int t = (idx + u * nthr) >> 7;
            float y[8];
            const unsigned zz0[4] = {z0[u].x, z0[u].y, z0[u].z, z0[u].w}, zz1[4] = {z1[u].x, z1[u].y, z1[u].z, z1[u].w}, zz2[4] = {z2[u].x, z2[u].y, z2[u].z, z2[u].w}, cc[4] = {cbv[u].x, cbv[u].y, cbv[u].z, cbv[u].w};
#pragma unroll
            for (int k = 0; k < 4; ++k) {
                const float wa0 = k < 2 ? w0a[2 * k] : w0b[2 * k - 4], wb0 = k < 2 ? w0a[2 * k + 1] : w0b[2 * k - 3];
                const float wa1 = k < 2 ? w1a[2 * k] : w1b[2 * k - 4], wb1 = k < 2 ? w1a[2 * k + 1] : w1b[2 * k - 3];
                const float wa2 = k < 2 ? w2a[2 * k] : w2b[2 * k - 4], wb2 = k < 2 ? w2a[2 * k + 1] : w2b[2 * k - 3];
                y[2 * k] = bf_lo(cc[k]) * (wa0 * bf_lo(zz2[k]) + wa1 * bf_lo(zz1[k]) + wa2 * bf_lo(zz0[k]));
                y[2 * k + 1] = bf_hi(cc[k]) * (wb0 * bf_hi(zz2[k]) + wb1 * bf_hi(zz1[k]) + wb2 * bf_hi(zz0[k]));
            }
            u32x4 w; w.x = cvt_pk_bf16(y[0], y[1]); w.y = cvt_pk_bf16(y[2], y[3]); w.z = cvt_pk_bf16(y[4], y[5]); w.w = cvt_pk_bf16(y[6], y[7]);
            *(u32x4*)(Yb + (size_t)t * D + 8 * c8) = w; }
    }
}

#define RLX_AGENT __ATOMIC_RELAXED, __HIP_MEMORY_SCOPE_AGENT
#define XB_TMO      128
#define XB_XCNT(j)  (256  + 64 * (j))
#define XB_XSUB(j)  (1280 + 64 * (j))
#define XB_XGEN(j)  (2304 + 64 * (j))
#define XB_TOP      3328
#define XB_TOPGEN   3392
#define XCD_BAR_WORDS 3456
#define XB_SPIN_CAP (1u << 18)

__device__ __forceinline__ unsigned xb_ld(unsigned* p)              { return __hip_atomic_load(p, __ATOMIC_RELAXED, __HIP_MEMORY_SCOPE_AGENT); }
__device__ __forceinline__ unsigned xb_add(unsigned* p, unsigned v) { return __hip_atomic_fetch_add(p, v, __ATOMIC_RELAXED, __HIP_MEMORY_SCOPE_AGENT); }
__device__ __forceinline__ unsigned xb_xcc_id() { return (unsigned)__builtin_amdgcn_s_getreg((3 << 11) | 20) & 0xFu; }
#define XB_SPIN(cond, bar) do { unsigned _sp = 0; while (cond) { __builtin_amdgcn_s_sleep(1); \
    if ((++_sp & 255u) == 0u) { if (xb_ld(&(bar)[XB_TMO])) break; if (_sp > XB_SPIN_CAP) { atomicAdd(&(bar)[XB_TMO], 1u); break; } } } } while (0)

struct XcdBarrier {
    unsigned* bar; unsigned x;
    volatile LAS unsigned* st;
};

__device__ __forceinline__ XcdBarrier xcd_barrier_post(unsigned* bar, volatile LAS unsigned* st) {
    XcdBarrier b; b.bar = bar; b.x = xb_xcc_id(); b.st = st;
    if (threadIdx.x == 0) (void)xb_add(&bar[XB_XCNT(b.x)], 1u);
    return b;
}
__device__ __forceinline__ void xcd_barrier_complete(unsigned* bar, unsigned x, unsigned& nloc, unsigned& nx) {
    const unsigned G = gridDim.x * gridDim.y * gridDim.z;
    unsigned sum, cnt, mine, sp = 0u;
    for (;;) {
        sum = 0u; cnt = 0u; mine = 0u;
#pragma unroll
        for (unsigned j = 0; j < 16; ++j) { const unsigned c = xb_ld(&bar[XB_XCNT(j)]); sum += c; cnt += (c > 0u) ? 1u : 0u; mine = (j == x) ? c : mine; }
        if (sum == G) break;
        __builtin_amdgcn_s_sleep(1);
        if ((++sp & 255u) == 0u) { if (xb_ld(&bar[XB_TMO])) break; if (sp > XB_SPIN_CAP) { atomicAdd(&bar[XB_TMO], 1u); break; } }
    }
    nloc = mine > 0u ? mine : 1u; nx = cnt > 0u ? cnt : 1u;
}

__device__ __forceinline__ void xcd_barrier(const XcdBarrier& b) {
    asm volatile("s_waitcnt vmcnt(0)" ::: "memory");
    __syncthreads();
    if (threadIdx.x == 0) {
        unsigned* bar = b.bar;
        __builtin_amdgcn_s_waitcnt(0);
        unsigned nloc = b.st[0], nx = b.st[1];
        if (nloc == 0u) { xcd_barrier_complete(bar, b.x, nloc, nx); b.st[0] = nloc; b.st[1] = nx; }
        const unsigned old = xb_add(&bar[XB_XSUB(b.x)], 1u);
        const unsigned gen = old / nloc;
        if (old + 1u == (gen + 1u) * nloc) {
            __builtin_amdgcn_fence(__ATOMIC_RELEASE, "agent");
            asm volatile("s_waitcnt vmcnt(0)" ::: "memory");
            const unsigned og = xb_add(&bar[XB_TOP], 1u);
            const unsigned tg = og / nx;
            if (og + 1u == (tg + 1u) * nx) xb_add(&bar[XB_TOPGEN], 1u);
            else XB_SPIN(xb_ld(&bar[XB_TOPGEN]) == tg, bar);
            __builtin_amdgcn_fence(__ATOMIC_ACQUIRE, "agent");
            xb_add(&bar[XB_XGEN(b.x)], 1u);
            asm volatile("s_waitcnt vmcnt(0)" ::: "memory");
        } else {
            XB_SPIN(xb_ld(&bar[XB_XGEN(b.x)]) == gen, bar);
            __builtin_amdgcn_fence(__ATOMIC_ACQUIRE, "agent");
            asm volatile("s_waitcnt vmcnt(0)" ::: "memory");
        }
    }
    __syncthreads();
}

struct Args { const float* in[21]; float* out; unsigned char* ws; int ph_lo, ph_hi, dump_mib, pad; };

__global__ void __launch_bounds__(512) hybrid_fwd(Args a) {
    extern __shared__ __attribute__((aligned(16))) unsigned char lds_raw[];
    LAS unsigned char* lds = (LAS unsigned char*)lds_raw;
#if MK_ONE_LAUNCH
    if (threadIdx.x < 2) ((volatile LAS unsigned*)(lds + MISC_OFF))[threadIdx.x] = 0u;
    __syncthreads();
    const XcdBarrier xbar = xcd_barrier_post((unsigned*)a.ws + CW_BAR, (volatile LAS unsigned*)(lds + MISC_OFF));
#endif
    for (int ph = a.ph_lo; ph < a.ph_hi; ++ph) {
        int tid = threadIdx.x; asm volatile("" : "+v"(tid));
        int G = gridDim.x, bx = blockIdx.x; asm volatile("" : "+s"(G), "+s"(bx));
        const int vcu = (G % 8 == 0) ? (bx % 8) * (G / 8) + bx / 8 : bx;
        const int lane = tid & 63, wave = __builtin_amdgcn_readfirstlane(tid >> 6);
        const int gw = vcu * 8 + wave, ngw = G * 8, gtid = vcu * 512 + tid, nthr = G * 512;
        const __attribute__((address_space(4))) Args* ap = (const __attribute__((address_space(4))) Args*)__builtin_amdgcn_kernarg_segment_ptr(); asm volatile("" : "+s"(ap));
        unsigned char* ws = ap->ws;
        bf16* H = (bf16*)ap->out;
        float* HF = (float*)(ws + WS_BIG + 176 * MiB);
        const float* mod = (const float*)(ws + WS_MOD);
        LAS float* scr = (LAS float*)(lds + wave * 8448);
        bf16* U = (bf16*)(ws + WS_U);
        unsigned char* big = ws + WS_BIG;
        bf16* Yb = (bf16*)(ws + WS_Y); bf16* Yc = (bf16*)(ws + WS_Y + PLANE); bf16* Ya = (bf16*)(ws + WS_Y + 2 * PLANE);
#if MK_ONE_LAUNCH
        if (ph > a.ph_lo) { if (a.ph_lo != 0 && ph == a.ph_lo + 1) cg::this_grid().sync(); else xcd_barrier(xbar); }
#endif
        if (ph == 100) {
            const bf16* src = (const bf16*)(ap->ws + (size_t)ap->dump_mib * MiB); float* o = ap->out;
            for (int i = vcu * 512 + tid; i < M * D; i += G * 512) o[i] = __uint_as_float(((unsigned)src[i]) << 16);
            continue; }
        if (ph == 0) { p0_phase(lds, ap->in[1], ap->in[2], ap->in[3], ws, vcu, G, tid, lane, wave); continue; }
        if (ph == NPHASE - 1) { final_norm_rows(HF, ap->out, ap->in[20], gw, ngw, lane); continue; }
#ifndef MK_DUP_NOP
#define MK_DUP_NOP 0
#endif
#ifdef MK_DUP_K
        const int l = (ph - 1) / 15, slot_ = (ph - 1) % 15, k = slot_ <= MK_DUP_K ? slot_ : slot_ - 1;
        const bool dupnop = (slot_ == MK_DUP_K + 1) && MK_DUP_NOP;
#else
        const int l = (ph - 1) / 14, k = (ph - 1) % 14;
        const bool dupnop = false;
#endif
        const float* modl = mod + (size_t)l * 8 * MODW;
        if (k == 1 || k == 12) {
            const pg8::Gemm g{U, (const bf16*)(ws + W_W13), M, 2 * DFF, D, D, 30, 0}; const pg8::EpiUp eu{(bf16*)big, dupnop};
            pg8::StaticOrder S; S.init(M, 2 * DFF, G, bx); pg8::gemm_phase<pg8::EpiUp>(lds, g, S, eu, tid);
        } else if (k == 2 || k == 13 || k == 10) {
            const bool wo = (k == 10); const int KK = wo ? D : DFF;
            const pg8::Gemm g{wo ? (const bf16*)U : (const bf16*)big, (const bf16*)(ws + (wo ? W_OUT : W_W2)), M, D, KK, KK, 30, 0};
            const bool first = (l == 0 && k == 2), lastres = (l == 1 && k == 13);
            const pg8::EpiRes er{first ? (const void*)ap->in[0] : (const void*)H, lastres ? (void*)HF : (void*)H, modl + (k == 2 ? 2 : (wo ? 5 : 8)) * D, wo ? 1.0f : 0.5f, first ? 0 : 1, lastres ? 0 : 1};
            pg8::StaticOrder S; S.init(M, D, G, bx); pg8::gemm_phase<pg8::EpiRes>(lds, g, S, er, tid);
        } else if (k == 4 || k == 6 || k == 8) {
            const int grp = k == 4 ? 0 : (k == 6 ? 1 : 2), roff = grp == 0 ? 0 : (grp == 1 ? 4096 : 8448), NN = grp == 0 ? 4096 : (grp == 1 ? 4352 : 3072);
            if (k == 6) { if (G == 256) { if (bx >= 128) ya_pass(Ya, (const bf16*)(big + 208 * MiB), (const float*)(ws + WS_SSQ), Ya, (bx - 128) * 512 + tid, 128 * 512); }
                          else ya_pass(Ya, (const bf16*)(big + 208 * MiB), (const float*)(ws + WS_SSQ), Ya, gtid, nthr); }
            const pg8::Gemm g{U, (const bf16*)(ws + W_IN) + (size_t)roff * D, M, NN, D, D, 30, 0}; const pg8::EpiProj ep{big, grp, (const float*)(ws + WS_ROT)};
            pg8::StaticOrder S; S.init(M, NN, G, bx); pg8::gemm_phase<pg8::EpiProj>(lds, g, S, ep, tid);
        } else if (k == 9) {
            const pg8::Gemm g{Yb, (const bf16*)(ws + W_PCAT), M, D, 3 * D, D, 4, PLANE}; const pg8::EpiMerge em{(const bf16*)big, U};
            pg8::StaticOrder S; S.init(M, D, G, bx); pg8::gemm_phase<pg8::EpiMerge>(lds, g, S, em, tid);
        } else if (k == 0) {
            norm_rows(l == 0 ? (const void*)ap->in[0] : (const void*)H, l == 0 ? 0 : 1, ap->in[4] + (size_t)l * D, modl + 0 * D, modl + 1 * D, U, gw, ngw, lane);
            convert_ffn(ap->in[5] + (size_t)l * D * DFF, ap->in[6] + (size_t)l * D * DFF, ap->in[7] + (size_t)l * D * DFF, ws, scr, gw, ngw, lane);
        } else if (k == 3) {
            norm_rows(H, 1, ap->in[8] + (size_t)l * D, modl + 3 * D, modl + 4 * D, U, gw, ngw, lane);
            convert_mixer(ap->in[9] + (size_t)l * D * INC, ap->in[12] + (size_t)l * D * D, ap->in[13] + (size_t)l * D * D, ap->in[14] + (size_t)l * D * D, ap->in[15] + (size_t)l * D * D, ws, scr, gw, ngw, lane);
        } else if (k == 11) {
            norm_rows(H, 1, ap->in[16] + (size_t)l * D, modl + 6 * D, modl + 7 * D, U, gw, ngw, lane);
            convert_ffn(ap->in[17] + (size_t)l * D * DFF, ap->in[18] + (size_t)l * D * DFF, ap->in[19] + (size_t)l * D * DFF, ws, scr, gw, ngw, lane);
        } else if (k == 5) {
#ifdef MK_SCAN_PMODE
            if (dupnop) scan_phase(lds, (const bf16*)big, (const bf16*)(big + PLANE), (const bf16*)(big + 2 * PLANE), Yc, (float*)(ws + WS_SSQ), vcu, tid, lane, wave, MK_SCAN_PMODE);
            else
#endif
            scan_phase(lds, (const bf16*)big, (const bf16*)(big + PLANE), (const bf16*)(big + 2 * PLANE), Ya, (float*)(ws + WS_SSQ), vcu, tid, lane, wave);
        } else if (k == 7) {
            const bool fuse = (G == 256);
            swa_phase(lds, (const bf16*)(big + 2 * PLANE), (const bf16*)(big + 3 * PLANE), Yc, ap->in[11] + (size_t)l * 16, vcu, G, tid, lane, wave,
                      fuse, (const bf16*)big, (const bf16*)(big + PLANE), ap->in[10] + (size_t)l * 3 * D, Yb, gtid, nthr);
            if (!fuse) conv_pass((const bf16*)big, (const bf16*)(big + PLANE), ap->in[10] + (size_t)l * 3 * D, Yb, gtid, nthr);
        }
    }
}

extern "C" void kernel_launch(void* const* d_in, const int* in_sizes, int n_in, void* d_out, int out_size, void* d_ws, size_t ws_size, hipStream_t stream) {
    static int grid = 0;
    if (grid == 0) {
        if (n_in != 21 || in_sizes[0] != M * D || out_size != M * D || ws_size < WS_END) { fprintf(stderr, "kernel_launch: unexpected shapes / workspace (n_in %d, in0 %d, out %d, ws %zu < %zu)\n", n_in, n_in > 0 ? in_sizes[0] : -1, out_size, ws_size, (size_t)WS_END); grid = -1; return; }
        if (hipFuncSetAttribute((const void*)hybrid_fwd, hipFuncAttributeMaxDynamicSharedMemorySize, LDS_BYTES) != hipSuccess) { fprintf(stderr, "kernel_launch: hipFuncSetAttribute failed\n"); grid = -1; return; }
        int dev = 0, cus = 0, per_cu = 0;
        (void)hipGetDevice(&dev); (void)hipDeviceGetAttribute(&cus, hipDeviceAttributeMultiprocessorCount, dev);
        (void)hipOccupancyMaxActiveBlocksPerMultiprocessor(&per_cu, (const void*)hybrid_fwd, 512, LDS_BYTES);
        (void)hipGetLastError();
        if (per_cu < 1) { fprintf(stderr, "kernel_launch: occupancy query says %d blocks per CU\n", per_cu); per_cu = 1; }
        grid = cus * 1;
        if (grid != 256) fprintf(stderr, "kernel_launch: note: %d CUs\n", grid);
    }
    if (grid < 0) return;
    Args a{};
    for (int i = 0; i < 21; ++i) a.in[i] = (const float*)d_in[i];
    a.out = (float*)d_out; a.ws = (unsigned char*)d_ws;
#if MK_ONE_LAUNCH
    if (hipMemsetAsync(d_ws, 0, CTL_ZERO_BYTES, stream) != hipSuccess) { fprintf(stderr, "kernel_launch: hipMemsetAsync failed\n"); return; }
    a.ph_lo = 0; a.ph_hi = NPHASE;
    void* args[] = {&a};
    hipError_t e = hipLaunchCooperativeKernel((const void*)hybrid_fwd, dim3(grid), dim3(512), args, LDS_BYTES, stream);
    if (e != hipSuccess) fprintf(stderr, "kernel_launch: cooperative launch failed: %s (grid %d)\n", hipGetErrorString(e), grid);
#else
#ifndef MK_CUT
#define MK_CUT NPHASE
#endif
    for (int ph = 0; ph < MK_CUT; ++ph) { a.ph_lo = ph; a.ph_hi = ph + 1; hipLaunchKernelGGL(hybrid_fwd, dim3(grid), dim3(512), LDS_BYTES, stream, a); }
#ifdef MK_DUMP
    a.ph_lo = 100; a.ph_hi = 101; a.dump_mib = MK_DUMP; hipLaunchKernelGGL(hybrid_fwd, dim3(grid), dim3(512), LDS_BYTES, stream, a);
#endif
#endif
}
```
